# Optimizing an MI355X kernel written in HIP

```python
import jax, jax.numpy as jnp
from jax import lax
import numpy as np

D_MODEL = 2048
BATCH = 1
SEQ = 16384
DEPTH = 1
DEC_BATCH = 16
DEC_SEQ = 32
PAST_LEN = 4096

CHUNK = 64
N_HEADS = 16
N_KV = 4
GQA = N_HEADS // N_KV
HEAD_DIM = 64
ATT_DIM = N_HEADS * HEAD_DIM
KV_DIM = N_KV * HEAD_DIM
WINDOW = 128
WIN_CHUNKS = WINDOW // CHUNK
GM_BLOCK = 128
GM_DIM = 1024
GM_GROUPS = 8
GM_GDIM = GM_DIM // GM_GROUPS
N_KEYS = 128
N_EXPERTS = N_KEYS * N_KEYS
PK_HEADS = 8
PK_HALF = 128
PK_DIM = 2 * PK_HALF
PK_TOPK = 16
PEER_BLOCK = 128
EPS = 1e-6
NEG = -1e30

SPLITS = (ATT_DIM,
          ATT_DIM + KV_DIM,
          ATT_DIM + 2 * KV_DIM,
          ATT_DIM + 2 * KV_DIM + GM_DIM,
          ATT_DIM + 2 * KV_DIM + 2 * GM_DIM,
          ATT_DIM + 2 * KV_DIM + 2 * GM_DIM + D_MODEL)
IN_DIM = SPLITS[-1] + D_MODEL

kernel_name = "chunk_stream_swa_gmlp_peer_step"


def rms_norm(x, g):
    xf = x.astype(jnp.float32)
    y = xf * lax.rsqrt(jnp.mean(xf * xf, axis=-1, keepdims=True) + EPS)
    return (y * g.astype(jnp.float32)).astype(x.dtype)


def layer_norm(x, g, b):
    xf = x.astype(jnp.float32)
    mu = jnp.mean(xf, axis=-1, keepdims=True)
    var = jnp.mean(jnp.square(xf - mu), axis=-1, keepdims=True)
    y = (xf - mu) * lax.rsqrt(var + EPS) * g.astype(jnp.float32) + b.astype(jnp.float32)
    return y.astype(x.dtype)


def attend_with_sinks(q, k, v, sinks, mask=None):
    s = jnp.einsum('...qkgd,...skd->...kgqs', q, k).astype(jnp.float32) * (HEAD_DIM ** -0.5)
    if mask is not None:
        s = jnp.where(mask, s, jnp.float32(NEG))
    sk = sinks.astype(jnp.float32).reshape(N_KV, GQA)[:, :, None, None]
    m = jnp.maximum(jnp.max(s, axis=-1, keepdims=True), sk)
    p = jnp.exp(s - m)
    p = p / (jnp.sum(p, axis=-1, keepdims=True) + jnp.exp(sk - m))
    return jnp.einsum('...kgqs,...skd->...qkgd', p.astype(v.dtype), v)


def swa_prompt(q, k, v, sinks):
    b, s = q.shape[:2]
    nc = s // CHUNK
    qc = q.reshape(b, nc, CHUNK, N_KV, GQA, HEAD_DIM)

    def band(t):
        tc = t.reshape(b, nc, CHUNK, N_KV, HEAD_DIM)
        tp = jnp.pad(tc, ((0, 0), (WIN_CHUNKS, 0), (0, 0), (0, 0), (0, 0)))
        return jnp.concatenate([tp[:, i:i + nc] for i in range(WIN_CHUNKS + 1)], axis=2)

    kb, vb = band(k), band(v)
    key_chunk = jnp.arange(nc)[:, None] - WIN_CHUNKS + jnp.arange(WIN_CHUNKS + 1)[None, :]
    valid = jnp.repeat(key_chunk >= 0, CHUNK, axis=1)
    mask = valid[None, :, None, None, None, :]
    o = attend_with_sinks(qc, kb, vb, sinks, mask)
    return o.reshape(b, s, ATT_DIM)


def swa_sample(q, k, v, cache_k, cache_v, sinks):
    db, t = q.shape[:2]
    qg = q.reshape(db, t, N_KV, GQA, HEAD_DIM)
    kk = jnp.concatenate([cache_k, k], axis=1)
    vv = jnp.concatenate([cache_v, v], axis=1)
    return attend_with_sinks(qg, kk, vv, sinks).reshape(db, t, ATT_DIM)


def gmlp_mask():
    i = jnp.arange(GM_BLOCK)
    return (i[None, :] // CHUNK) <= (i[:, None] // CHUNK)


def gmlp_prompt(u, vg, ws, bias):
    b, s = u.shape[:2]
    vb = vg.reshape(b, s // GM_BLOCK, GM_BLOCK, GM_GROUPS, GM_GDIM)
    w = jnp.where(gmlp_mask()[None], ws, 0)
    mixed = jnp.einsum('gij,bnjgc->bnigc', w, vb) + bias.T[:, :, None]
    return u * mixed.reshape(b, s, GM_DIM)


def gmlp_sample(u, vg, ws, bias):
    db, t = u.shape[:2]
    w = jnp.where(gmlp_mask()[:t, :t][None], ws[:, :t, :t], 0)
    mixed = jnp.einsum('gij,bjgc->bigc', w, vg.reshape(db, t, GM_GROUPS, GM_GDIM)) + bias.T[:t, :, None]
    return u * mixed.reshape(db, t, GM_DIM)


def peer(h, pk_wq, pk_keys, peer_u, peer_v):
    lead = h.shape[:-1]
    xt = h.reshape(-1, D_MODEL)
    n = xt.shape[0]
    nblk = -(-n // PEER_BLOCK)
    xt = jnp.pad(xt, ((0, nblk * PEER_BLOCK - n), (0, 0)))

    def retrieve(xb):
        q = (xb @ pk_wq).reshape(PEER_BLOCK, PK_HEADS, 2, PK_HALF)
        s = jnp.einsum('thpd,hpnd->thpn', q, pk_keys).astype(jnp.float32)
        sv, si = lax.top_k(s, PK_TOPK)
        cand = (sv[:, :, 0, :, None] + sv[:, :, 1, None, :]).reshape(PEER_BLOCK, PK_HEADS, PK_TOPK * PK_TOPK)
        cv, ci = lax.top_k(cand, PK_TOPK)
        i1 = jnp.take_along_axis(si[:, :, 0], ci // PK_TOPK, axis=-1)
        i2 = jnp.take_along_axis(si[:, :, 1], ci % PK_TOPK, axis=-1)
        eid = i1 * N_KEYS + i2
        g = jax.nn.softmax(cv, axis=-1)
        a = jax.nn.gelu(jnp.einsum('thkd,td->thk', peer_u[eid], xb)).astype(jnp.float32)
        return jnp.einsum('thk,thkd->td', (g * a).astype(xb.dtype), peer_v[eid])

    y = lax.map(retrieve, xt.reshape(nblk, PEER_BLOCK, D_MODEL))
    return y.reshape(nblk * PEER_BLOCK, D_MODEL)[:n].reshape(*lead, D_MODEL)


def _layer(x, c, cache_k, cache_v, w_mod, b_mod, g_norm1, w_in, attn_sinks, gm_ln_g, gm_ln_b, gm_ws, gm_b,
           w_branch_a, w_branch_b, w_out, g_norm2, pk_wq, pk_keys, peer_u, peer_v):
    nb, t = x.shape[:2]
    mod = (jax.nn.silu(c) @ w_mod + b_mod)[:, None, :]
    sh1, sc1, gt1, sh2, sc2, gt2 = jnp.split(mod, 6, axis=-1)
    h = rms_norm(x, g_norm1) * (1 + sc1) + sh1
    q, k, v, gu, gv, ga, gb = jnp.split(h @ w_in, SPLITS, axis=-1)
    q = q.reshape(nb, t, N_HEADS, HEAD_DIM)
    k = k.reshape(nb, t, N_KV, HEAD_DIM)
    v = v.reshape(nb, t, N_KV, HEAD_DIM)
    u = jax.nn.gelu(gu)
    vg = layer_norm(jax.nn.gelu(gv), gm_ln_g, gm_ln_b)
    if cache_k is None:
        o_a = swa_prompt(q, k, v, attn_sinks)
        o_b = gmlp_prompt(u, vg, gm_ws, gm_b)
        new_state = (k[:, -WINDOW:], v[:, -WINDOW:])
    else:
        o_a = swa_sample(q, k, v, cache_k, cache_v, attn_sinks)
        o_b = gmlp_sample(u, vg, gm_ws, gm_b)
        new_state = (k, v, vg)
    mix = jax.nn.sigmoid(ga) * (o_a @ w_branch_a) + jax.nn.sigmoid(gb) * (o_b @ w_branch_b)
    x = x + gt1 * (mix @ w_out)
    h2 = rms_norm(x, g_norm2) * (1 + sc2) + sh2
    x = x + gt2 * peer(h2, pk_wq, pk_keys, peer_u, peer_v)
    return x, new_state


def setup_inputs(seed: int = 0) -> dict:
    key = jax.random.key(seed)
    ks = jax.random.split(key, 24)
    f32 = jnp.float32
    rows = min(WINDOW, PAST_LEN)
    nrm = lambda k_, shape, sc: jax.random.normal(k_, shape, f32) * sc
    return {
        "x_prompt": nrm(ks[0], (BATCH, SEQ, D_MODEL), 1.0),
        "x_sample": nrm(ks[1], (DEC_BATCH, DEC_SEQ, D_MODEL), 1.0),
        "cache_k": nrm(ks[2], (DEPTH, DEC_BATCH, rows, N_KV, HEAD_DIM), 1.0),
        "cache_v": nrm(ks[3], (DEPTH, DEC_BATCH, rows, N_KV, HEAD_DIM), 1.0),
        "c_prompt": nrm(ks[4], (BATCH, D_MODEL), 1.0),
        "c_sample": nrm(ks[5], (DEC_BATCH, D_MODEL), 1.0),
        "w_mod": nrm(ks[6], (DEPTH, D_MODEL, 6 * D_MODEL), D_MODEL ** -0.5),
        "b_mod": nrm(ks[7], (DEPTH, 6 * D_MODEL), 0.01),
        "g_norm1": 1.0 + nrm(ks[8], (DEPTH, D_MODEL), 0.01),
        "w_in": nrm(ks[9], (DEPTH, D_MODEL, IN_DIM), D_MODEL ** -0.5),
        "attn_sinks": nrm(ks[10], (DEPTH, N_HEADS), 1.0),
        "gm_ln_g": 1.0 + nrm(ks[11], (DEPTH, GM_DIM), 0.01),
        "gm_ln_b": nrm(ks[12], (DEPTH, GM_DIM), 0.01),
        "gm_ws": nrm(ks[13], (DEPTH, GM_GROUPS, GM_BLOCK, GM_BLOCK), GM_BLOCK ** -0.5),
        "gm_b": 1.0 + nrm(ks[14], (DEPTH, GM_GROUPS, GM_BLOCK), 0.01),
        "w_branch_a": nrm(ks[15], (DEPTH, ATT_DIM, D_MODEL), ATT_DIM ** -0.5),
        "w_branch_b": nrm(ks[16], (DEPTH, GM_DIM, D_MODEL), GM_DIM ** -0.5),
        "w_out": nrm(ks[17], (DEPTH, D_MODEL, D_MODEL), D_MODEL ** -0.5),
        "g_norm2": 1.0 + nrm(ks[18], (DEPTH, D_MODEL), 0.01),
        "pk_wq": nrm(ks[19], (DEPTH, D_MODEL, PK_HEADS * PK_DIM), D_MODEL ** -0.5),
        "pk_keys": nrm(ks[20], (DEPTH, PK_HEADS, 2, N_KEYS, PK_HALF), PK_HALF ** -0.5),
        "peer_u": nrm(ks[21], (DEPTH, N_EXPERTS, D_MODEL), D_MODEL ** -0.5),
        "peer_v": nrm(ks[22], (DEPTH, N_EXPERTS, D_MODEL), (PK_HEADS * PK_TOPK) ** -0.5),
        "g_final": 1.0 + nrm(ks[23], (D_MODEL,), 0.01),
    }


def reference(x_prompt, x_sample, cache_k, cache_v, c_prompt, c_sample, w_mod, b_mod, g_norm1, w_in,
              attn_sinks, gm_ln_g, gm_ln_b, gm_ws, gm_b, w_branch_a, w_branch_b, w_out, g_norm2,
              pk_wq, pk_keys, peer_u, peer_v, g_final):
    xp, xs = x_prompt, x_sample
    kp, vp, ksm, vsm, gsm = [], [], [], [], []
    for l in range(DEPTH):
        w = (w_mod[l], b_mod[l], g_norm1[l], w_in[l], attn_sinks[l], gm_ln_g[l], gm_ln_b[l], gm_ws[l], gm_b[l],
             w_branch_a[l], w_branch_b[l], w_out[l], g_norm2[l], pk_wq[l], pk_keys[l], peer_u[l], peer_v[l])
        xp, (k_p, v_p) = _layer(xp, c_prompt, None, None, *w)
        xs, (k_s, v_s, g_s) = _layer(xs, c_sample, cache_k[l], cache_v[l], *w)
        kp.append(k_p)
        vp.append(v_p)
        ksm.append(k_s)
        vsm.append(v_s)
        gsm.append(g_s)
    y_prompt = rms_norm(xp, g_final)
    y_sample = rms_norm(xs, g_final)
    return (y_prompt, y_sample, jnp.stack(kp), jnp.stack(vp), jnp.stack(ksm), jnp.stack(vsm), jnp.stack(gsm))
```

```cpp
#include <hip/hip_runtime.h>
#include <hip/hip_cooperative_groups.h>
#include <cstdio>
namespace cg = cooperative_groups;
namespace pg8 {
#define PG8_LAS __attribute__((address_space(3)))
typedef unsigned short bf16_t;
typedef short bf16x8 __attribute__((ext_vector_type(8)));
typedef float f32x4 __attribute__((ext_vector_type(4)));
typedef unsigned u32x4 __attribute__((ext_vector_type(4)));
constexpr int BM = 256, BK = 64, HALF = 128, HTB = HALF * BK * 2  , STAGE_BYTES = 8 * HTB, NXCD = 8, WGM = 8;

__host__ __device__ __forceinline__ int lds_byte(int r, int c) { const int st = (r >> 4) * 2 + (c >> 5), rr = r & 15, cc = c & 31, ob = rr * 64 + cc * 2; return st * 1024 + (ob ^ (((ob >> 9) & 1) << 5)); }
__host__ __device__ __forceinline__ void stage_rc(int b, int& R, int& C) { const int st = b / 1024, sb = b % 1024, swz = sb ^ (((sb >> 9) & 1) << 5); R = (st >> 1) * 16 + swz / 64; C = (st & 1) * 32 + (swz % 64) / 2; }
__host__ __device__ __forceinline__ int perm32(int rho) { const int n = rho >> 4, i = rho & 15; return 8 * (i >> 2) + 4 * n + (i & 3); }

struct Unit { int pm, pn; };
struct Gemm { const bf16_t* A; const bf16_t* Bt; int M, N, K; };

struct StaticOrder {
    int nM, nN, nwg, G, c;
    __host__ __device__ void init(int M, int N, int G_, int c_) { nM = M / BM; nN = N / BM; nwg = nM * nN; G = G_; c = c_; }
    __host__ __device__ bool next(int i, Unit& u) const {
        const long L = (long)i * G + c; if (L >= nwg) return false;
        int wgid = (int)L; { const int q = nwg / NXCD, r = nwg % NXCD, xcd = wgid % NXCD, off = wgid / NXCD; wgid = (xcd < r ? xcd * (q + 1) : r * (q + 1) + (xcd - r) * q) + off; }
        const int nig = WGM * nN, gid = wgid / nig, fm = gid * WGM, gsz = (nM - fm) < WGM ? (nM - fm) : WGM;
        u.pm = fm + ((wgid % nig) % gsz); u.pn = (wgid % nig) / gsz; return true;
    }
    __device__ __forceinline__ void a_ready(const Unit&) const {}
    __device__ __forceinline__ void done(const Unit&) const {}
};
typedef __bf16 bf16pair_t __attribute__((ext_vector_type(2)));
typedef float f32pair_t __attribute__((ext_vector_type(2)));
__device__ __forceinline__ unsigned cvt_pk_bf16(float lo, float hi) { const f32pair_t v = {lo, hi}; return __builtin_bit_cast(unsigned, __builtin_convertvector(v, bf16pair_t)); }
template <class Epi, class Sched, bool STAMP = false>
__device__ __forceinline__ void gemm_phase(PG8_LAS unsigned char* lds, const Gemm g, const Sched& S, const Epi& E, unsigned long long* stamps) {
    const int tid = threadIdx.x, wid = __builtin_amdgcn_readfirstlane(tid >> 6), lane = tid & 63, wr = wid >> 2, wc = wid & 3, fr = lane & 15, fq = lane >> 4;
    const int K = g.K, nt = K / BK;
    unsigned voffA[2], voffB[2];
#pragma unroll
    for (int i = 0; i < 2; ++i) { int R, C; stage_rc(tid * 16 + i * 8192, R, C); const int Rb = Epi::PERM ? ((R & ~31) + perm32(R & 31)) : R;
        voffA[i] = (unsigned)(R * K + C) * 2u; voffB[i] = (unsigned)(Rb * K + C) * 2u; }
    const size_t kstep = (size_t)(BK * 2);
    const size_t hstep = (size_t)HALF * K * 2;
    const size_t tstep = 2 * hstep;
    const unsigned ldsw = (unsigned)wid * 1024u;
    const int aoff = lds_byte(wr * 64 + fr, fq * 8), boff = lds_byte(wc * 32 + fr, fq * 8);
#define PG8_SA(b, h) (((b) * 2 + (h)) * HTB)
#define PG8_SB(b, h) ((4 + (b) * 2 + (h)) * HTB)
#define PG8_STAGE(bufoff, gbase, voff) do { _Pragma("unroll") for (int _i = 0; _i < 2; ++_i) \
        __builtin_amdgcn_global_load_lds((const unsigned*)((const char*)(gbase) + (voff)[_i]), (PG8_LAS unsigned*)(lds + (bufoff) + ldsw + _i * 8192), 16, 0, 0); } while (0)
#define PG8_LDA(dst, b, h) do { _Pragma("unroll") for (int m = 0; m < 4; ++m) _Pragma("unroll") for (int k = 0; k < 2; ++k) dst[m][k] = *(const PG8_LAS bf16x8*)(lds + PG8_SA(b, h) + aoff + m * 2048 + k * 1024); } while (0)
#define PG8_LDB(dst, b, h) do { _Pragma("unroll") for (int n = 0; n < 2; ++n) _Pragma("unroll") for (int k = 0; k < 2; ++k) dst[n][k] = *(const PG8_LAS bf16x8*)(lds + PG8_SB(b, h) + boff + n * 2048 + k * 1024); } while (0)
#define PG8_MMA(ai, bj, At, Bt) do { __builtin_amdgcn_s_setprio(1); _Pragma("unroll") for (int m = 0; m < 4; ++m) _Pragma("unroll") for (int n = 0; n < 2; ++n) _Pragma("unroll") for (int k = 0; k < 2; ++k) \
        acc[ai][bj][m][n] = __builtin_amdgcn_mfma_f32_16x16x32_bf16(Bt[n][k], At[m][k], acc[ai][bj][m][n], 0, 0, 0); __builtin_amdgcn_s_setprio(0); } while (0)
#define PG8_WAIT_V(n) asm volatile("s_waitcnt vmcnt(" #n ")" ::: "memory")
#define PG8_WAIT_L(n) asm volatile("s_waitcnt lgkmcnt(" #n ")" ::: "memory")
#define PG8_BAR __builtin_amdgcn_s_barrier()
#define PG8_SCHED __builtin_amdgcn_sched_barrier(0)
    Unit cur, nxt; int ui = 0;
    if (!S.next(0, cur)) return;
    f32x4 acc[2][2][4][2];
#pragma unroll
    for (int a = 0; a < 2; ++a)
#pragma unroll
        for (int b = 0; b < 2; ++b)
#pragma unroll
            for (int m = 0; m < 4; ++m)
#pragma unroll
                for (int n = 0; n < 2; ++n) acc[a][b][m][n] = (f32x4){0.f, 0.f, 0.f, 0.f};
    bf16x8 At[4][2], B0[2][2], B1[2][2];
    const char* cA = (const char*)g.A + (size_t)cur.pm * tstep; const char* cB = (const char*)g.Bt + (size_t)cur.pn * tstep;
    S.a_ready(cur);
    PG8_STAGE(PG8_SB(0, 0), cB, voffB); PG8_STAGE(PG8_SA(0, 0), cA, voffA); PG8_STAGE(PG8_SB(0, 1), cB + hstep, voffB); PG8_STAGE(PG8_SA(0, 1), cA + hstep, voffA);
    if (wr == 1) PG8_BAR;
    PG8_WAIT_V(4); PG8_BAR;
    PG8_STAGE(PG8_SB(1, 0), cB + kstep, voffB); PG8_STAGE(PG8_SA(1, 0), cA + kstep, voffA); PG8_STAGE(PG8_SB(1, 1), cB + hstep + kstep, voffB);
    PG8_WAIT_V(6); PG8_BAR;
    for (;;) {
        const bool has_next = S.next(ui + 1, nxt);
        const char* nA = has_next ? (const char*)g.A + (size_t)nxt.pm * tstep : cA; const char* nB = has_next ? (const char*)g.Bt + (size_t)nxt.pn * tstep : cB;
        for (int t = 0; t < nt; t += 2) {
            const bool last = (t == nt - 2);
            const char* a1 = cA + (size_t)(t + 1) * kstep;
            const char* a2 = last ? nA : cA + (size_t)(t + 2) * kstep; const char* b2 = last ? nB : cB + (size_t)(t + 2) * kstep;
            const char* a3 = a2 + kstep; const char* b3 = b2 + kstep;
            if (last && has_next) S.a_ready(nxt);
            PG8_LDB(B0, 0, 0); PG8_SCHED; PG8_LDA(At, 0, 0); PG8_STAGE(PG8_SA(1, 1), a1 + hstep, voffA);
            PG8_WAIT_L(8); PG8_BAR; PG8_WAIT_L(0); PG8_MMA(0, 0, At, B0); PG8_BAR; PG8_SCHED;
            PG8_LDB(B1, 0, 1); PG8_STAGE(PG8_SB(0, 0), b2, voffB);
            PG8_BAR; PG8_WAIT_L(0); PG8_MMA(0, 1, At, B1); PG8_BAR;
            PG8_LDA(At, 0, 1); PG8_STAGE(PG8_SA(0, 0), a2, voffA);
            PG8_BAR; PG8_WAIT_L(0); PG8_MMA(1, 0, At, B0); PG8_BAR; PG8_SCHED;
            PG8_STAGE(PG8_SB(0, 1), b2 + hstep, voffB);
            PG8_WAIT_V(6); PG8_BAR; PG8_MMA(1, 1, At, B1); PG8_BAR;
            PG8_LDB(B0, 1, 0); PG8_SCHED; PG8_LDA(At, 1, 0); PG8_STAGE(PG8_SA(0, 1), a2 + hstep, voffA);
            PG8_WAIT_L(8); PG8_BAR; PG8_WAIT_L(0); PG8_MMA(0, 0, At, B0); PG8_BAR; PG8_SCHED;
            PG8_LDB(B1, 1, 1); PG8_STAGE(PG8_SB(1, 0), b3, voffB);
            PG8_BAR; PG8_WAIT_L(0); PG8_MMA(0, 1, At, B1); PG8_BAR;
            PG8_LDA(At, 1, 1); PG8_STAGE(PG8_SA(1, 0), a3, voffA);
            PG8_BAR; PG8_WAIT_L(0); PG8_MMA(1, 0, At, B0); PG8_BAR; PG8_SCHED;
            PG8_STAGE(PG8_SB(1, 1), b3 + hstep, voffB);
            PG8_WAIT_V(6); PG8_BAR; PG8_MMA(1, 1, At, B1); PG8_BAR;
        }
        if constexpr (!Epi::AFTER_DRAIN) { E(acc, cur, wr, wc, fr, fq); S.done(cur); }
        if (!has_next) break;
#pragma unroll
        for (int a = 0; a < 2; ++a)
#pragma unroll
            for (int b = 0; b < 2; ++b)
#pragma unroll
                for (int m = 0; m < 4; ++m)
#pragma unroll
                    for (int n = 0; n < 2; ++n) acc[a][b][m][n] = (f32x4){0.f, 0.f, 0.f, 0.f};
        cur = nxt; cA = nA; cB = nB; ++ui;
    }
    PG8_WAIT_V(0);
    if (wr == 0) PG8_BAR;
    PG8_BAR;
    if constexpr (Epi::AFTER_DRAIN) { E.fused(acc, cur, wr, wc, fr, fq, lds, wid, lane); S.done(cur); }
#undef PG8_SA
#undef PG8_SB
#undef PG8_STAGE
#undef PG8_LDA
#undef PG8_LDB
#undef PG8_MMA
#undef PG8_WAIT_V
#undef PG8_WAIT_L
#undef PG8_BAR
#undef PG8_SCHED
}
}

#define LAS __attribute__((address_space(3)))
typedef unsigned short bf16_t;
typedef short bf16x8 __attribute__((ext_vector_type(8)));
typedef float f32x4 __attribute__((ext_vector_type(4)));
typedef float f32x2 __attribute__((ext_vector_type(2)));
typedef unsigned u32x4 __attribute__((ext_vector_type(4)));
typedef unsigned u32x2 __attribute__((ext_vector_type(2)));
typedef int i32x4 __attribute__((ext_vector_type(4)));

constexpr int DM = 2048, MP = 16384, MS = 512, MT = MP + MS;
constexpr int IN_DIM = 7680;
constexpr int NEXP = 16384;
constexpr int LDS_BYTES = 140 * 1024;

constexpr size_t WS_WIN = 0;
constexpr size_t WS_WA = WS_WIN + (size_t)IN_DIM * DM * 2;
constexpr size_t WS_WB = WS_WA + (size_t)2048 * 1024 * 2;
constexpr size_t WS_WOUT = WS_WB + (size_t)2048 * 1024 * 2;
constexpr size_t WS_WQ = WS_WOUT + (size_t)2048 * 2048 * 2;
constexpr size_t WS_KEYS = WS_WQ + (size_t)2048 * 2048 * 2;
constexpr size_t WS_WM = WS_KEYS + (size_t)262144 * 2;
constexpr size_t WS_PU = WS_WM + (size_t)131072 * 2;
constexpr size_t WS_PV = WS_PU + (size_t)NEXP * DM * 2;
constexpr size_t WS_MOD = WS_PV + (size_t)NEXP * DM * 2;
constexpr size_t WS_H = WS_MOD + (size_t)17 * 12288 * 4;
constexpr size_t WS_Q = WS_H + (size_t)MT * 2048 * 2;
constexpr size_t WS_KB = WS_Q + (size_t)MT * 1024 * 2;
constexpr size_t WS_VB = WS_KB + (size_t)MT * 256 * 2;
constexpr size_t WS_U = WS_VB + (size_t)MT * 256 * 2;
constexpr size_t WS_GV = WS_U + (size_t)MT * 1024 * 2;
constexpr size_t WS_SGA = WS_GV + (size_t)MT * 1024 * 2;
constexpr size_t WS_SGB = WS_SGA + (size_t)MT * 2048 * 2;
constexpr size_t WS_END = WS_SGB + (size_t)MT * 2048 * 2;
constexpr size_t WS_EID = WS_SGB;
constexpr size_t WS_GW = WS_SGB + (size_t)MT * 128 * 4;

constexpr size_t O_Y = 0, O_KP = (size_t)MT * DM, O_VP = O_KP + 32768, O_KS = O_VP + 32768, O_VS = O_KS + 131072, O_GVS = O_VS + 131072;

struct Params {
    const float* x_prompt; const float* x_sample; const float* cache_k; const float* cache_v; const float* c_prompt; const float* c_sample;
    const float* w_mod; const float* b_mod; const float* g_norm1; const float* w_in; const float* sinks; const float* ln_g; const float* ln_b;
    const float* gm_ws; const float* gm_b; const float* w_a; const float* w_b; const float* w_out; const float* g_norm2; const float* pk_wq;
    const float* pk_keys; const float* peer_u; const float* peer_v; const float* g_final;
    float* out; unsigned char* ws; int ph_lo, ph_hi;
};

__device__ __forceinline__ float bf2f(unsigned short b) { return __uint_as_float(((unsigned)b) << 16); }
__device__ __forceinline__ float bflo(unsigned w) { return __uint_as_float(w << 16); }
__device__ __forceinline__ float bfhi(unsigned w) { return __uint_as_float(w & 0xffff0000u); }
using pg8::cvt_pk_bf16;
__device__ __forceinline__ float fast_exp(float x) { return __builtin_amdgcn_exp2f(x * 1.4426950408889634f); }
__device__ __forceinline__ float sigmoidf_(float x) { return __builtin_amdgcn_rcpf(1.0f + fast_exp(-x)); }
__device__ __forceinline__ float gelu_tanh(float x) { const float t = 1.5957691216057308f * (x + 0.044715f * x * x * x); return x * sigmoidf_(t); }
__device__ __forceinline__ float wave_sum(float v) {
#pragma unroll
    for (int o = 32; o >= 1; o >>= 1) v += __shfl_xor(v, o);
    return v;
}
__device__ __forceinline__ const float* xrow_ptr(const Params& p, int row) { return row < MP ? p.x_prompt + (size_t)row * DM : p.x_sample + (size_t)(row - MP) * DM; }
__device__ __forceinline__ int stream_of(int row) { return row < MP ? 0 : 1 + ((row - MP) >> 5); }

constexpr int P0_MOD = 192, P0_TR_WIN = 32 * 120, P0_TR_WA = 16 * 32, P0_TR_WO = 32 * 32;
constexpr int P0_TR0 = P0_MOD, P0_TR1 = P0_TR0 + P0_TR_WIN, P0_TR2 = P0_TR1 + P0_TR_WA, P0_TR3 = P0_TR2 + P0_TR_WA, P0_TR4 = P0_TR3 + P0_TR_WO, P0_TR5 = P0_TR4 + P0_TR_WO;
constexpr int P0_CV0 = P0_TR5, P0_CV1 = P0_CV0 + 4096, P0_CV2 = P0_CV1 + 4096, P0_CV3 = P0_CV2 + 32, P0_END = P0_CV3 + 16;

__device__ __forceinline__ void prep_transpose(LAS unsigned char* lds, const float* __restrict__ W, bf16_t* __restrict__ Wt, int K, int N, int tile) {
    LAS float* T = (LAS float*)lds;
    const int tn = N / 64; const int k0 = (tile / tn) * 64, n0 = (tile % tn) * 64; const int t = threadIdx.x;
#pragma unroll
    for (int i = 0; i < 8; ++i) { const int kk = i * 8 + (t >> 6), nn = t & 63; T[kk * 65 + nn] = W[(size_t)(k0 + kk) * N + n0 + nn]; }
    __syncthreads();
#pragma unroll
    for (int i = 0; i < 4; ++i) { const int nn = i * 16 + (t >> 5), kk = (t & 31) * 2;
        const unsigned w = cvt_pk_bf16(T[kk * 65 + nn], T[(kk + 1) * 65 + nn]);
        *(unsigned*)(Wt + (size_t)(n0 + nn) * K + k0 + kk) = w; }
    __syncthreads();
}
__device__ __forceinline__ void prep_convert(const float* __restrict__ src, bf16_t* __restrict__ dst, int unit, bool mask_gm) {
    const size_t e0 = (size_t)unit * 8192 + (size_t)threadIdx.x * 8;
#pragma unroll
    for (int j = 0; j < 2; ++j) { const size_t e = e0 + (size_t)j * 4096;
        f32x4 a = *(const f32x4*)(src + e), b = *(const f32x4*)(src + e + 4);
        if (mask_gm) { const int i = (int)((e >> 7) & 127), jj = (int)(e & 127); if ((jj >> 6) > (i >> 6)) { a = (f32x4){0.f, 0.f, 0.f, 0.f}; b = a; } }
        u32x4 w; w.x = cvt_pk_bf16(a[0], a[1]); w.y = cvt_pk_bf16(a[2], a[3]); w.z = cvt_pk_bf16(b[0], b[1]); w.w = cvt_pk_bf16(b[2], b[3]);
        *(u32x4*)(dst + e) = w; }
}
__device__ __forceinline__ void prep_mod(const Params& p, LAS unsigned char* lds, int unit) {
    LAS float* SC = (LAS float*)lds;
    const int t = threadIdx.x;
    for (int i = t; i < 17 * 2048; i += 512) { const int r = i >> 11, k = i & 2047; const float c = r == 0 ? p.c_prompt[k] : p.c_sample[(r - 1) * 2048 + k]; SC[i] = c * sigmoidf_(c); }
    __syncthreads();
    const int cgp = t & 15, ks = t >> 4; const int n0 = unit * 64 + cgp * 4;
    f32x4 acc[17];
#pragma unroll
    for (int r = 0; r < 17; ++r) acc[r] = (f32x4){0.f, 0.f, 0.f, 0.f};
    const float* wp = p.w_mod + (size_t)(ks * 64) * 12288 + n0;
    for (int k4 = 0; k4 < 64; k4 += 4) {
        f32x4 w0 = *(const f32x4*)(wp + (size_t)(k4 + 0) * 12288), w1 = *(const f32x4*)(wp + (size_t)(k4 + 1) * 12288), w2 = *(const f32x4*)(wp + (size_t)(k4 + 2) * 12288), w3 = *(const f32x4*)(wp + (size_t)(k4 + 3) * 12288);
#pragma unroll
        for (int r = 0; r < 17; ++r) { const f32x4 s = *(const LAS f32x4*)(SC + r * 2048 + ks * 64 + k4);
            acc[r] += w0 * s[0]; acc[r] += w1 * s[1]; acc[r] += w2 * s[2]; acc[r] += w3 * s[3]; }
    }
#pragma unroll
    for (int r = 0; r < 17; ++r)
#pragma unroll
        for (int j = 0; j < 4; ++j) { float v = acc[r][j]; v += __shfl_xor(v, 16); v += __shfl_xor(v, 32); acc[r][j] = v; }
    __syncthreads();
    LAS float* R = (LAS float*)lds;
    const int wv = t >> 6, lane = t & 63;
    if (lane < 16) {
#pragma unroll
        for (int r = 0; r < 17; ++r) *(LAS f32x4*)(R + (wv * 17 + r) * 64 + lane * 4) = acc[r]; }
    __syncthreads();
    float* MOD = (float*)(p.ws + WS_MOD);
    for (int i = t; i < 17 * 64; i += 512) { const int r = i >> 6, c = i & 63; float s = 0.f;
#pragma unroll
        for (int w = 0; w < 8; ++w) s += R[(w * 17 + r) * 64 + c];
        MOD[r * 12288 + unit * 64 + c] = s + p.b_mod[unit * 64 + c]; }
    __syncthreads();
}
__device__ __forceinline__ void phase_prep(const Params& p, LAS unsigned char* lds) {
    for (int u = blockIdx.x; u < P0_END; u += gridDim.x) {
        if (u < P0_MOD) prep_mod(p, lds, u);
        else if (u < P0_TR1) prep_transpose(lds, p.w_in, (bf16_t*)(p.ws + WS_WIN), 2048, IN_DIM, u - P0_TR0);
        else if (u < P0_TR2) prep_transpose(lds, p.w_a, (bf16_t*)(p.ws + WS_WA), 1024, 2048, u - P0_TR1);
        else if (u < P0_TR3) prep_transpose(lds, p.w_b, (bf16_t*)(p.ws + WS_WB), 1024, 2048, u - P0_TR2);
        else if (u < P0_TR4) prep_transpose(lds, p.w_out, (bf16_t*)(p.ws + WS_WOUT), 2048, 2048, u - P0_TR3);
        else if (u < P0_TR5) prep_transpose(lds, p.pk_wq, (bf16_t*)(p.ws + WS_WQ), 2048, 2048, u - P0_TR4);
        else if (u < P0_CV1) prep_convert(p.peer_u, (bf16_t*)(p.ws + WS_PU), u - P0_CV0, false);
        else if (u < P0_CV2) prep_convert(p.peer_v, (bf16_t*)(p.ws + WS_PV), u - P0_CV1, false);
        else if (u < P0_CV3) prep_convert(p.pk_keys, (bf16_t*)(p.ws + WS_KEYS), u - P0_CV2, false);
        else prep_convert(p.gm_ws, (bf16_t*)(p.ws + WS_WM), u - P0_CV3, true);
    }
}

__device__ __forceinline__ void phase_norm(const Params& p, int which) {
    const int lane = threadIdx.x & 63, wv = threadIdx.x >> 6;
    const float* MOD = (const float*)(p.ws + WS_MOD);
    const float* gn = which ? p.g_norm2 : p.g_norm1;
    const int sh_off = which ? 6144 : 0, sc_off = which ? 8192 : 2048;
    bf16_t* H = (bf16_t*)(p.ws + WS_H);
    int cur_s = -1; f32x4 mul[8], add[8];
    for (int row = blockIdx.x * 8 + wv; row < MT; row += gridDim.x * 8) {
        const int s = stream_of(row);
        if (s != cur_s) { cur_s = s;
#pragma unroll
            for (int j = 0; j < 8; ++j) { const int e = j * 256 + lane * 4; const f32x4 g = *(const f32x4*)(gn + e), sc = *(const f32x4*)(MOD + s * 12288 + sc_off + e), sh = *(const f32x4*)(MOD + s * 12288 + sh_off + e);
                mul[j] = g * (sc + 1.0f); add[j] = sh; } }
        const float* xr = which ? (p.out + O_Y + (size_t)row * DM) : xrow_ptr(p, row);
        f32x4 v[8]; float ss = 0.f;
#pragma unroll
        for (int j = 0; j < 8; ++j) { v[j] = *(const f32x4*)(xr + j * 256 + lane * 4); ss += v[j][0] * v[j][0] + v[j][1] * v[j][1] + v[j][2] * v[j][2] + v[j][3] * v[j][3]; }
        ss = wave_sum(ss);
        const float rstd = __builtin_amdgcn_rsqf(ss * (1.0f / 2048.0f) + 1e-6f);
#pragma unroll
        for (int j = 0; j < 8; ++j) { const f32x4 o = v[j] * rstd * mul[j] + add[j]; u32x2 w; w.x = cvt_pk_bf16(o[0], o[1]); w.y = cvt_pk_bf16(o[2], o[3]);
            *(u32x2*)(H + (size_t)row * DM + j * 256 + lane * 4) = w; }
    }
}

struct EpiIn {
    static constexpr bool PERM = true, AFTER_DRAIN = false;
    unsigned char* ws; float* out;
    __device__ __forceinline__ void operator()(const f32x4 (&acc)[2][2][4][2], const pg8::Unit& u, int wr, int wc, int fr, int fq) const {
        const int pn = u.pn; bf16_t* base; int ldc, colt, act;
        if (pn < 4) { base = (bf16_t*)(ws + WS_Q); ldc = 1024; colt = pn * 256; act = 0; }
        else if (pn == 4) { base = (bf16_t*)(ws + WS_KB); ldc = 256; colt = 0; act = 0; }
        else if (pn == 5) { base = (bf16_t*)(ws + WS_VB); ldc = 256; colt = 0; act = 0; }
        else if (pn < 10) { base = (bf16_t*)(ws + WS_U); ldc = 1024; colt = (pn - 6) * 256; act = 1; }
        else if (pn < 14) { base = (bf16_t*)(ws + WS_GV); ldc = 1024; colt = (pn - 10) * 256; act = 1; }
        else if (pn < 22) { base = (bf16_t*)(ws + WS_SGA); ldc = 2048; colt = (pn - 14) * 256; act = 2; }
        else { base = (bf16_t*)(ws + WS_SGB); ldc = 2048; colt = (pn - 22) * 256; act = 2; }
        const int row0 = u.pm * 256 + wr * 64 + fr, col0 = colt + wc * 32 + 8 * fq;
        const bool kv = (pn == 4 || pn == 5);
#pragma unroll
        for (int ai = 0; ai < 2; ++ai)
#pragma unroll
            for (int m = 0; m < 4; ++m) { const int row = row0 + ai * 128 + m * 16; bf16_t* rowp = base + (size_t)row * ldc + col0;
#pragma unroll
                for (int bj = 0; bj < 2; ++bj) { f32x4 v0 = acc[ai][bj][m][0], v1 = acc[ai][bj][m][1];
                    if (act == 1) {
#pragma unroll
                        for (int j = 0; j < 4; ++j) { v0[j] = gelu_tanh(v0[j]); v1[j] = gelu_tanh(v1[j]); } }
                    else if (act == 2) {
#pragma unroll
                        for (int j = 0; j < 4; ++j) { v0[j] = sigmoidf_(v0[j]); v1[j] = sigmoidf_(v1[j]); } }
                    if (kv && row >= MP - 128) {
                        float* o = out + (pn == 4 ? (row < MP ? O_KP : O_KS) : (row < MP ? O_VP : O_VS)) + (size_t)(row < MP ? row - (MP - 128) : row - MP) * 256 + col0 + bj * 128;
                        *(f32x4*)o = v0; *(f32x4*)(o + 4) = v1; }
                    u32x4 w; w.x = cvt_pk_bf16(v0[0], v0[1]); w.y = cvt_pk_bf16(v0[2], v0[3]); w.z = cvt_pk_bf16(v1[0], v1[1]); w.w = cvt_pk_bf16(v1[2], v1[3]);
                    *(u32x4*)(rowp + bj * 128) = w; } }
    }
};
template <int SECOND> struct EpiMix {
    static constexpr bool PERM = true, AFTER_DRAIN = false;
    const bf16_t* gate; bf16_t* mix;
    __device__ __forceinline__ void operator()(const f32x4 (&acc)[2][2][4][2], const pg8::Unit& u, int wr, int wc, int fr, int fq) const {
        const int row0 = u.pm * 256 + wr * 64 + fr, col0 = u.pn * 256 + wc * 32 + 8 * fq;
#pragma unroll
        for (int ai = 0; ai < 2; ++ai)
#pragma unroll
            for (int m = 0; m < 4; ++m) { const size_t off = (size_t)(row0 + ai * 128 + m * 16) * 2048 + col0;
#pragma unroll
                for (int bj = 0; bj < 2; ++bj) { const u32x4 g = *(const u32x4*)(gate + off + bj * 128); const f32x4 a0 = acc[ai][bj][m][0], a1 = acc[ai][bj][m][1];
                    float r[8] = {bflo(g.x) * a0[0], bfhi(g.x) * a0[1], bflo(g.y) * a0[2], bfhi(g.y) * a0[3], bflo(g.z) * a1[0], bfhi(g.z) * a1[1], bflo(g.w) * a1[2], bfhi(g.w) * a1[3]};
                    if (SECOND) { const u32x4 o = *(const u32x4*)(mix + off + bj * 128);
                        r[0] += bflo(o.x); r[1] += bfhi(o.x); r[2] += bflo(o.y); r[3] += bfhi(o.y); r[4] += bflo(o.z); r[5] += bfhi(o.z); r[6] += bflo(o.w); r[7] += bfhi(o.w); }
                    u32x4 w; w.x = cvt_pk_bf16(r[0], r[1]); w.y = cvt_pk_bf16(r[2], r[3]); w.z = cvt_pk_bf16(r[4], r[5]); w.w = cvt_pk_bf16(r[6], r[7]);
                    *(u32x4*)(mix + off + bj * 128) = w; } }
    }
};
struct EpiX1 {
    static constexpr bool PERM = false, AFTER_DRAIN = false;
    const float* x_prompt; const float* x_sample; const float* MOD; float* out;
    __device__ __forceinline__ void operator()(const f32x4 (&acc)[2][2][4][2], const pg8::Unit& u, int wr, int wc, int fr, int fq) const {
        const int row0 = u.pm * 256 + wr * 64 + fr, col0 = u.pn * 256 + wc * 32 + 4 * fq;
#pragma unroll
        for (int ai = 0; ai < 2; ++ai)
#pragma unroll
            for (int m = 0; m < 4; ++m) { const int row = row0 + ai * 128 + m * 16;
                const float* xr = (row < MP ? x_prompt + (size_t)row * DM : x_sample + (size_t)(row - MP) * DM) + col0;
                const float* gt = MOD + stream_of(row) * 12288 + 4096 + col0; float* o = out + O_Y + (size_t)row * DM + col0;
#pragma unroll
                for (int bj = 0; bj < 2; ++bj)
#pragma unroll
                    for (int n = 0; n < 2; ++n) { const int c = bj * 128 + n * 16; *(f32x4*)(o + c) = *(const f32x4*)(xr + c) + *(const f32x4*)(gt + c) * acc[ai][bj][m][n]; } }
    }
};
struct EpiQP {
    static constexpr bool PERM = true, AFTER_DRAIN = false;
    bf16_t* qp;
    __device__ __forceinline__ void operator()(const f32x4 (&acc)[2][2][4][2], const pg8::Unit& u, int wr, int wc, int fr, int fq) const {
        const int row0 = u.pm * 256 + wr * 64 + fr, col0 = u.pn * 256 + wc * 32 + 8 * fq;
#pragma unroll
        for (int ai = 0; ai < 2; ++ai)
#pragma unroll
            for (int m = 0; m < 4; ++m) { bf16_t* rowp = qp + (size_t)(row0 + ai * 128 + m * 16) * 2048 + col0;
#pragma unroll
                for (int bj = 0; bj < 2; ++bj) { const f32x4 v0 = acc[ai][bj][m][0], v1 = acc[ai][bj][m][1];
                    u32x4 w; w.x = cvt_pk_bf16(v0[0], v0[1]); w.y = cvt_pk_bf16(v0[2], v0[3]); w.z = cvt_pk_bf16(v1[0], v1[1]); w.w = cvt_pk_bf16(v1[2], v1[3]);
                    *(u32x4*)(rowp + bj * 128) = w; } }
    }
};
#define MFMA16(a, b, c) __builtin_amdgcn_mfma_f32_16x16x32_bf16((a), (b), (c), 0, 0, 0)
constexpr int ATT_KS = 72, ATT_VS = 200;
constexpr int N_ATT_P = 1024, N_ATT_S = 64, N_GM_P = 1024, N_GM_S = 128, N_MIX_ITEMS = N_ATT_P + N_ATT_S + N_GM_P + N_GM_S;

__device__ __forceinline__ void attn_item(const Params& p, LAS unsigned char* lds, int item) {
    LAS bf16_t* Ks = (LAS bf16_t*)lds;
    LAS bf16_t* Vt = (LAS bf16_t*)(lds + 192 * ATT_KS * 2);
    const int t = threadIdx.x, lane = t & 63, wv = t >> 6, n = lane & 15, q = lane >> 4;
    const bf16_t* KB = (const bf16_t*)(p.ws + WS_KB); const bf16_t* VB = (const bf16_t*)(p.ws + WS_VB);
    bf16_t* Q = (bf16_t*)(p.ws + WS_Q); bf16_t* OAp = Q;
    int kvh, tok0, nq, kv_lo, kv_hi, chunk = 0, sb = 0; const bool samp = item >= N_ATT_P;
    if (!samp) { chunk = item >> 2; kvh = item & 3; tok0 = chunk * 64; nq = 64; kv_lo = chunk >= 2 ? 0 : (chunk == 1 ? 64 : 128); kv_hi = 192; }
    else { const int it = item - N_ATT_P; sb = it >> 2; kvh = it & 3; tok0 = MP + sb * 32; nq = 32; kv_lo = 0; kv_hi = 160; }
#pragma unroll
    for (int i = 0; i < 3; ++i) { const int pr = t + i * 512, key = pr >> 3, seg = pr & 7;
        u32x4 kw = (u32x4){0u, 0u, 0u, 0u}, vw = kw;
        if (key >= kv_lo && key < kv_hi) {
            if (!samp) { const size_t r = (size_t)((chunk - 2) * 64 + key); kw = *(const u32x4*)(KB + r * 256 + kvh * 64 + seg * 8); vw = *(const u32x4*)(VB + r * 256 + kvh * 64 + seg * 8); }
            else if (key >= 128) { const size_t r = (size_t)(MP + sb * 32 + key - 128); kw = *(const u32x4*)(KB + r * 256 + kvh * 64 + seg * 8); vw = *(const u32x4*)(VB + r * 256 + kvh * 64 + seg * 8); }
            else { const size_t o = ((size_t)(sb * 128 + key) * 4 + kvh) * 64 + seg * 8;
                const f32x4 a = *(const f32x4*)(p.cache_k + o), b = *(const f32x4*)(p.cache_k + o + 4), c = *(const f32x4*)(p.cache_v + o), d = *(const f32x4*)(p.cache_v + o + 4);
                kw.x = cvt_pk_bf16(a[0], a[1]); kw.y = cvt_pk_bf16(a[2], a[3]); kw.z = cvt_pk_bf16(b[0], b[1]); kw.w = cvt_pk_bf16(b[2], b[3]);
                vw.x = cvt_pk_bf16(c[0], c[1]); vw.y = cvt_pk_bf16(c[2], c[3]); vw.z = cvt_pk_bf16(d[0], d[1]); vw.w = cvt_pk_bf16(d[2], d[3]); } }
        *(LAS u32x4*)(Ks + key * ATT_KS + seg * 8) = kw;
        const int kin = key & 31, pos = (key & ~31) + 8 * ((kin >> 2) & 3) + 4 * (kin >> 4) + (kin & 3);
        LAS bf16_t* vp = Vt + (seg * 8) * ATT_VS + pos;
        vp[0 * ATT_VS] = (bf16_t)(vw.x & 0xffff); vp[1 * ATT_VS] = (bf16_t)(vw.x >> 16); vp[2 * ATT_VS] = (bf16_t)(vw.y & 0xffff); vp[3 * ATT_VS] = (bf16_t)(vw.y >> 16);
        vp[4 * ATT_VS] = (bf16_t)(vw.z & 0xffff); vp[5 * ATT_VS] = (bf16_t)(vw.z >> 16); vp[6 * ATT_VS] = (bf16_t)(vw.w & 0xffff); vp[7 * ATT_VS] = (bf16_t)(vw.w >> 16); }
    __syncthreads();
    const int g = wv >> 1, half = wv & 1, h = kvh * 4 + g;
    if (half * 32 < nq) {
        const int qrow0 = tok0 + half * 32;
        bf16x8 Qf[2][2];
#pragma unroll
        for (int qb = 0; qb < 2; ++qb)
#pragma unroll
            for (int s = 0; s < 2; ++s) Qf[qb][s] = *(const bf16x8*)(Q + (size_t)(qrow0 + qb * 16 + n) * 1024 + h * 64 + s * 32 + q * 8);
        f32x4 S[12][2];
#pragma unroll
        for (int kb = 0; kb < 12; ++kb) {
            const bf16x8 a0 = *(const LAS bf16x8*)(Ks + (kb * 16 + n) * ATT_KS + q * 8), a1 = *(const LAS bf16x8*)(Ks + (kb * 16 + n) * ATT_KS + 32 + q * 8);
#pragma unroll
            for (int qb = 0; qb < 2; ++qb) { f32x4 c = (f32x4){0.f, 0.f, 0.f, 0.f}; c = MFMA16(a0, Qf[qb][0], c); c = MFMA16(a1, Qf[qb][1], c); S[kb][qb] = c; } }
        const float sink = p.sinks[h];
        bf16x8 Pf[6][2];
#pragma unroll
        for (int qb = 0; qb < 2; ++qb) {
            float mx = sink;
#pragma unroll
            for (int kb = 0; kb < 12; ++kb)
#pragma unroll
                for (int j = 0; j < 4; ++j) { const int key = kb * 16 + 4 * q + j; const bool ok = key >= kv_lo && key < kv_hi; const float s = ok ? S[kb][qb][j] * 0.125f : -1e30f; S[kb][qb][j] = s; mx = fmaxf(mx, s); }
            mx = fmaxf(mx, __shfl_xor(mx, 16)); mx = fmaxf(mx, __shfl_xor(mx, 32));
            float sum = 0.f;
#pragma unroll
            for (int kb = 0; kb < 12; ++kb)
#pragma unroll
                for (int j = 0; j < 4; ++j) { const float e = fast_exp(S[kb][qb][j] - mx); S[kb][qb][j] = e; sum += e; }
            sum += __shfl_xor(sum, 16); sum += __shfl_xor(sum, 32);
            const float inv = 1.0f / (sum + fast_exp(sink - mx));
#pragma unroll
            for (int kp = 0; kp < 6; ++kp) { const f32x4 a = S[2 * kp][qb] * inv, b = S[2 * kp + 1][qb] * inv;
                u32x4 w; w.x = cvt_pk_bf16(a[0], a[1]); w.y = cvt_pk_bf16(a[2], a[3]); w.z = cvt_pk_bf16(b[0], b[1]); w.w = cvt_pk_bf16(b[2], b[3]);
                Pf[kp][qb] = __builtin_bit_cast(bf16x8, w); }
        }
#pragma unroll
        for (int db = 0; db < 4; ++db) {
            f32x4 o0 = (f32x4){0.f, 0.f, 0.f, 0.f}, o1 = o0;
#pragma unroll
            for (int kp = 0; kp < 6; ++kp) { const bf16x8 a = *(const LAS bf16x8*)(Vt + (db * 16 + n) * ATT_VS + kp * 32 + q * 8); o0 = MFMA16(a, Pf[kp][0], o0); o1 = MFMA16(a, Pf[kp][1], o1); }
            u32x2 w0, w1; w0.x = cvt_pk_bf16(o0[0], o0[1]); w0.y = cvt_pk_bf16(o0[2], o0[3]); w1.x = cvt_pk_bf16(o1[0], o1[1]); w1.y = cvt_pk_bf16(o1[2], o1[3]);
            *(u32x2*)(OAp + (size_t)(qrow0 + n) * 1024 + h * 64 + db * 16 + 4 * q) = w0;
            *(u32x2*)(OAp + (size_t)(qrow0 + 16 + n) * 1024 + h * 64 + db * 16 + 4 * q) = w1; }
    }
    __syncthreads();
}

constexpr int GM_S = 136;
__device__ __forceinline__ void gmlp_item(const Params& p, LAS unsigned char* lds, int item) {
    LAS bf16_t* VgT = (LAS bf16_t*)lds;
    LAS bf16_t* WmS = (LAS bf16_t*)(lds + 128 * GM_S * 2);
    LAS float* ST = (LAS float*)(lds + 2 * 128 * GM_S * 2);
    const int t = threadIdx.x, lane = t & 63, wv = t >> 6, n = lane & 15, q = lane >> 4;
    const bf16_t* GV = (const bf16_t*)(p.ws + WS_GV); bf16_t* U = (bf16_t*)(p.ws + WS_U); const bf16_t* WM = (const bf16_t*)(p.ws + WS_WM);
    int g, tok0, ntok, sb = 0; const bool samp = item >= N_GM_P;
    if (!samp) { g = item & 7; tok0 = (item >> 3) * 128; ntok = 128; } else { const int it = item - N_GM_P; g = it & 7; sb = it >> 3; tok0 = MP + sb * 32; ntok = 32; }
    for (int i = 0; i < 16; ++i) { const int j = wv * 16 + i; if (j >= ntok) break;
        const bf16_t* r = GV + (size_t)(tok0 + j) * 1024 + lane * 8; const u32x4 a = *(const u32x4*)r, b = *(const u32x4*)(r + 512);
        const float v[16] = {bflo(a.x), bfhi(a.x), bflo(a.y), bfhi(a.y), bflo(a.z), bfhi(a.z), bflo(a.w), bfhi(a.w), bflo(b.x), bfhi(b.x), bflo(b.y), bfhi(b.y), bflo(b.z), bfhi(b.z), bflo(b.w), bfhi(b.w)};
        float s = 0.f, ss = 0.f;
#pragma unroll
        for (int e = 0; e < 16; ++e) { s += v[e]; ss += v[e] * v[e]; }
        s = wave_sum(s); ss = wave_sum(ss);
        const float mean = s * (1.0f / 1024.0f), var = fmaxf(ss * (1.0f / 1024.0f) - mean * mean, 0.f);
        if (lane == 0) { ST[j * 2] = mean; ST[j * 2 + 1] = __builtin_amdgcn_rsqf(var + 1e-6f); } }
#pragma unroll
    for (int i = 0; i < 4; ++i) { const int c = t + i * 512, row = c >> 4, sg = c & 15; *(LAS u32x4*)(WmS + row * GM_S + sg * 8) = *(const u32x4*)(WM + (size_t)g * 16384 + row * 128 + sg * 8); }
    __syncthreads();
    { const int sg = (t & 15) * 8; f32x4 lg0 = *(const f32x4*)(p.ln_g + g * 128 + sg), lg1 = *(const f32x4*)(p.ln_g + g * 128 + sg + 4), lb0 = *(const f32x4*)(p.ln_b + g * 128 + sg), lb1 = *(const f32x4*)(p.ln_b + g * 128 + sg + 4);
#pragma unroll
        for (int it = 0; it < 4; ++it) { const int j = (t >> 4) + 32 * it; float o[8];
            if (j < ntok) { const u32x4 a = *(const u32x4*)(GV + (size_t)(tok0 + j) * 1024 + g * 128 + sg); const float mean = ST[j * 2], rstd = ST[j * 2 + 1];
                const float v[8] = {bflo(a.x), bfhi(a.x), bflo(a.y), bfhi(a.y), bflo(a.z), bfhi(a.z), bflo(a.w), bfhi(a.w)};
#pragma unroll
                for (int e = 0; e < 8; ++e) o[e] = (v[e] - mean) * rstd * (e < 4 ? lg0[e & 3] : lg1[e & 3]) + (e < 4 ? lb0[e & 3] : lb1[e & 3]);
                if (samp) { float* d = p.out + O_GVS + (size_t)(sb * 32 + j) * 1024 + g * 128 + sg; *(f32x4*)d = (f32x4){o[0], o[1], o[2], o[3]}; *(f32x4*)(d + 4) = (f32x4){o[4], o[5], o[6], o[7]}; } }
            else {
#pragma unroll
                for (int e = 0; e < 8; ++e) o[e] = 0.f; }
#pragma unroll
            for (int e = 0; e < 8; e += 2) { const unsigned w = cvt_pk_bf16(o[e], o[e + 1]); VgT[(sg + e) * GM_S + j] = (bf16_t)(w & 0xffff); VgT[(sg + e + 1) * GM_S + j] = (bf16_t)(w >> 16); } } }
    __syncthreads();
    if (wv * 16 < ntok) {
        const int i = wv * 16 + n; bf16x8 Bf[4];
#pragma unroll
        for (int ks = 0; ks < 4; ++ks) Bf[ks] = *(const LAS bf16x8*)(WmS + i * GM_S + ks * 32 + q * 8);
        const float bias = p.gm_b[g * 128 + i];
#pragma unroll
        for (int cb = 0; cb < 8; ++cb) { f32x4 c = (f32x4){0.f, 0.f, 0.f, 0.f};
#pragma unroll
            for (int ks = 0; ks < 4; ++ks) { const bf16x8 a = *(const LAS bf16x8*)(VgT + (cb * 16 + n) * GM_S + ks * 32 + q * 8); c = MFMA16(a, Bf[ks], c); }
            bf16_t* up = U + (size_t)(tok0 + i) * 1024 + g * 128 + cb * 16 + 4 * q; const u32x2 uw = *(const u32x2*)up;
            u32x2 w; w.x = cvt_pk_bf16(bflo(uw.x) * (c[0] + bias), bfhi(uw.x) * (c[1] + bias)); w.y = cvt_pk_bf16(bflo(uw.y) * (c[2] + bias), bfhi(uw.y) * (c[3] + bias));
            *(u32x2*)up = w; }
    }
    __syncthreads();
}
__device__ __forceinline__ void phase_mixers(const Params& p, LAS unsigned char* lds) {
    for (int it = blockIdx.x; it < N_MIX_ITEMS; it += gridDim.x) {
        if (it < N_ATT_P + N_ATT_S) attn_item(p, lds, it); else gmlp_item(p, lds, it - (N_ATT_P + N_ATT_S));
    }
}

constexpr int TK_KS = 136, TK_QS = 264, TK_SS = 129;
constexpr int TK_OFF_Q = 2 * 128 * TK_KS * 2;
constexpr int TK_OFF_L = TK_OFF_Q + 64 * TK_QS * 2;
__device__ __forceinline__ int f2key(float f) { const int b = __float_as_int(f); return b ^ ((b >> 31) & 0x7fffffff); }
__device__ __forceinline__ float key2f(int k) { return __int_as_float(k ^ ((k >> 31) & 0x7fffffff)); }
#define CE_DESC(a, b) do { const int _hi = max((a), (b)), _lo = min((a), (b)); (a) = _hi; (b) = _lo; } while (0)
__device__ __forceinline__ void bubble16(int (&a)[16], int v) {
#pragma unroll
    for (int j = 0; j < 16; ++j) { const int hi = max(a[j], v); v = min(a[j], v); a[j] = hi; }
}
__device__ __forceinline__ void merge16(int (&a)[16], const int (&o)[16]) {
#pragma unroll
    for (int j = 0; j < 16; ++j) a[j] = max(a[j], o[15 - j]);
#pragma unroll
    for (int d = 8; d >= 1; d >>= 1)
#pragma unroll
        for (int j = 0; j < 16; ++j) if ((j & d) == 0) CE_DESC(a[j], a[j + d]);
}
__device__ __forceinline__ void topk_item(const Params& p, LAS unsigned char* lds, int item) {
    LAS bf16_t* KS = (LAS bf16_t*)lds;
    LAS bf16_t* QS = (LAS bf16_t*)(lds + TK_OFF_Q);
    LAS float* SC = (LAS float*)lds;
    LAS int* L4 = (LAS int*)(lds + TK_OFF_L);
    const int t = threadIdx.x, lane = t & 63, wv = t >> 6, n = lane & 15, q = lane >> 4;
    const int h = item & 7, tok0 = (item >> 3) * 64;
    const bf16_t* KEYS = (const bf16_t*)(p.ws + WS_KEYS) + (size_t)h * 32768; const bf16_t* QP = (const bf16_t*)(p.ws + WS_SGA);
#pragma unroll
    for (int i = 0; i < 8; ++i) { const int c = t + i * 512, row = c >> 4, sg = c & 15; *(LAS u32x4*)(KS + row * TK_KS + sg * 8) = *(const u32x4*)(KEYS + (size_t)row * 128 + sg * 8); }
#pragma unroll
    for (int i = 0; i < 4; ++i) { const int c = t + i * 512, row = c >> 5, sg = c & 31; *(LAS u32x4*)(QS + row * TK_QS + sg * 8) = *(const u32x4*)(QP + (size_t)(tok0 + row) * 2048 + h * 256 + sg * 8); }
    __syncthreads();
    const int pp = wv >> 2, nb0 = (wv & 3) * 2;
    f32x4 acc[2][4];
#pragma unroll
    for (int a = 0; a < 2; ++a)
#pragma unroll
        for (int b = 0; b < 4; ++b) acc[a][b] = (f32x4){0.f, 0.f, 0.f, 0.f};
#pragma unroll
    for (int ks = 0; ks < 4; ++ks) {
        bf16x8 Af[2], Bq[4];
#pragma unroll
        for (int a = 0; a < 2; ++a) Af[a] = *(const LAS bf16x8*)(KS + (pp * 128 + (nb0 + a) * 16 + n) * TK_KS + ks * 32 + q * 8);
#pragma unroll
        for (int b = 0; b < 4; ++b) Bq[b] = *(const LAS bf16x8*)(QS + (b * 16 + n) * TK_QS + pp * 128 + ks * 32 + q * 8);
#pragma unroll
        for (int a = 0; a < 2; ++a)
#pragma unroll
            for (int b = 0; b < 4; ++b) acc[a][b] = MFMA16(Af[a], Bq[b], acc[a][b]);
    }
    __syncthreads();
#pragma unroll
    for (int a = 0; a < 2; ++a)
#pragma unroll
        for (int b = 0; b < 4; ++b) { LAS float* d = SC + (pp * 64 + b * 16 + n) * TK_SS + (nb0 + a) * 16 + 4 * q;
            d[0] = acc[a][b][0]; d[1] = acc[a][b][1]; d[2] = acc[a][b][2]; d[3] = acc[a][b][3]; }
    __syncthreads();
    const int inst = t & 127, part = t >> 7;
    int a[16];
#pragma unroll
    for (int j = 0; j < 16; ++j) a[j] = (int)0x80000000;
    { const LAS float* src = SC + inst * TK_SS + part * 32;
#pragma unroll
        for (int i = 0; i < 32; ++i) { const int key = (f2key(src[i]) & ~127) | (part * 32 + i); bubble16(a, key); } }
#pragma unroll
    for (int j = 0; j < 16; ++j) L4[(inst * 4 + part) * 16 + j] = a[j];
    __syncthreads();
    if ((part & 1) == 0) { int o[16];
#pragma unroll
        for (int j = 0; j < 16; ++j) o[j] = L4[(inst * 4 + part + 1) * 16 + j];
        merge16(a, o);
#pragma unroll
        for (int j = 0; j < 16; ++j) L4[(inst * 4 + part) * 16 + j] = a[j]; }
    __syncthreads();
    if (part == 0) { int o[16];
#pragma unroll
        for (int j = 0; j < 16; ++j) o[j] = L4[(inst * 4 + 2) * 16 + j];
        merge16(a, o);
#pragma unroll
        for (int j = 0; j < 16; ++j) L4[(inst * 4) * 16 + j] = a[j]; }
    __syncthreads();
    int b[16];
#pragma unroll
    for (int j = 0; j < 16; ++j) b[j] = (int)0x80000000;
    const int tk = t & 63, cp = (t >> 6) & 3;
    const LAS int* L0 = L4 + tk * 64; const LAS int* L1 = L4 + (64 + tk) * 64;
    if (t < 256) {
        float f1[16];
#pragma unroll
        for (int j = 0; j < 16; ++j) f1[j] = key2f(L1[j] & ~127);
#pragma unroll
        for (int ii = 0; ii < 4; ++ii) { const int i = cp + 4 * ii; const float f0 = key2f(L0[i] & ~127);
            const int jmax = ii == 0 ? 16 : (ii == 1 ? 3 : 1);
#pragma unroll
            for (int j = 0; j < jmax; ++j) { const bool ok = (i + 1) * (j + 1) <= 16; const int key = ok ? ((f2key(f0 + f1[j]) & ~255) | (i * 16 + j)) : (int)0x80000000; bubble16(b, key); } }
        LAS int* C4 = (LAS int*)lds;
#pragma unroll
        for (int j = 0; j < 16; ++j) C4[(tk * 4 + cp) * 16 + j] = b[j];
    }
    __syncthreads();
    LAS int* C4 = (LAS int*)lds;
    if (t < 256 && (cp & 1) == 0) { int o[16];
#pragma unroll
        for (int j = 0; j < 16; ++j) o[j] = C4[(tk * 4 + cp + 1) * 16 + j];
        merge16(b, o);
#pragma unroll
        for (int j = 0; j < 16; ++j) C4[(tk * 4 + cp) * 16 + j] = b[j]; }
    __syncthreads();
    if (t < 64) { int o[16];
#pragma unroll
        for (int j = 0; j < 16; ++j) o[j] = C4[(tk * 4 + 2) * 16 + j];
        merge16(b, o);
        float cv[16], e[16]; float sum = 0.f;
#pragma unroll
        for (int k = 0; k < 16; ++k) cv[k] = key2f(b[k] & ~255);
#pragma unroll
        for (int k = 0; k < 16; ++k) { e[k] = fast_exp(cv[k] - cv[0]); sum += e[k]; }
        const float inv = 1.0f / sum;
        int* EID = (int*)(p.ws + WS_EID) + (size_t)(tok0 + tk) * 128 + h * 16; float* GW = (float*)(p.ws + WS_GW) + (size_t)(tok0 + tk) * 128 + h * 16;
#pragma unroll
        for (int k4 = 0; k4 < 4; ++k4) { i32x4 ev; f32x4 gv;
#pragma unroll
            for (int kk = 0; kk < 4; ++kk) { const int k = k4 * 4 + kk, code = b[k] & 255; const int i1 = L0[code >> 4] & 127, i2 = L1[code & 15] & 127; ev[kk] = i1 * 128 + i2; gv[kk] = e[k] * inv; }
            *(i32x4*)(EID + k4 * 4) = ev; *(f32x4*)(GW + k4 * 4) = gv; }
    }
    __syncthreads();
}
__device__ __forceinline__ void phase_topk(const Params& p, LAS unsigned char* lds) {
    for (int it = blockIdx.x; it < (MT / 64) * 8; it += gridDim.x) topk_item(p, lds, it);
}

__device__ __forceinline__ float dot2bf(unsigned a, unsigned b, float c) {
    typedef __bf16 bf2 __attribute__((ext_vector_type(2)));
    return __builtin_amdgcn_fdot2_f32_bf16(__builtin_bit_cast(bf2, a), __builtin_bit_cast(bf2, b), c, false);
}
__device__ __forceinline__ float dot8(const u32x4 a, const u32x4 b, float c) { c = dot2bf(a.x, b.x, c); c = dot2bf(a.y, b.y, c); c = dot2bf(a.z, b.z, c); c = dot2bf(a.w, b.w, c); return c; }
__device__ __forceinline__ void peer_token(const Params& p, int row, int lane) {
    const bf16_t* H2 = (const bf16_t*)(p.ws + WS_H); const bf16_t* PU = (const bf16_t*)(p.ws + WS_PU); const bf16_t* PV = (const bf16_t*)(p.ws + WS_PV);
    const int* EID = (const int*)(p.ws + WS_EID) + (size_t)row * 128; const float* GW = (const float*)(p.ws + WS_GW) + (size_t)row * 128;
    u32x4 hv[4];
#pragma unroll
    for (int c = 0; c < 4; ++c) hv[c] = *(const u32x4*)(H2 + (size_t)row * DM + c * 512 + lane * 8);
    const int e0 = EID[lane], e1 = EID[64 + lane]; const float g0 = GW[lane], g1 = GW[64 + lane];
    float a0 = 0.f, a1 = 0.f;
    const int b0 = lane & 1, b1 = (lane >> 1) & 1;
#pragma unroll 1
    for (int hh = 0; hh < 2; ++hh) { const int ev = hh ? e1 : e0; float av = 0.f;
#pragma unroll 1
        for (int k0 = 0; k0 < 64; k0 += 4) {
            float pr[4];
#pragma unroll
            for (int e = 0; e < 4; ++e) { const int src = k0 + ((e & 1) << 1) + (e >> 1); const int id = __builtin_amdgcn_readlane(ev, src);
                const bf16_t* ur = PU + (size_t)id * DM + lane * 8; float s = 0.f;
#pragma unroll
                for (int c = 0; c < 4; ++c) s = dot8(*(const u32x4*)(ur + c * 512), hv[c], s);
                pr[e] = s; }
            const float r0 = (b0 ? pr[2] : pr[0]) + __shfl_xor(b0 ? pr[0] : pr[2], 1);
            const float r1 = (b0 ? pr[3] : pr[1]) + __shfl_xor(b0 ? pr[1] : pr[3], 1);
            float tt = (b1 ? r1 : r0) + __shfl_xor(b1 ? r0 : r1, 2);
            tt += __shfl_xor(tt, 4); tt += __shfl_xor(tt, 8); tt += __shfl_xor(tt, 16); tt += __shfl_xor(tt, 32);
            if ((lane & ~3) == k0) av = tt;
        }
        if (hh) a1 = av; else a0 = av; }
    const float w0 = g0 * gelu_tanh(a0), w1 = g1 * gelu_tanh(a1);
    float acc[4][8];
#pragma unroll
    for (int c = 0; c < 4; ++c)
#pragma unroll
        for (int j = 0; j < 8; ++j) acc[c][j] = 0.f;
#pragma unroll 1
    for (int hh = 0; hh < 2; ++hh) { const int ev = hh ? e1 : e0; const float wvv = hh ? w1 : w0;
#pragma unroll 1
        for (int k0 = 0; k0 < 64; k0 += 4) {
#pragma unroll
            for (int e = 0; e < 4; ++e) { const int id = __builtin_amdgcn_readlane(ev, k0 + e); const float wk = __int_as_float(__builtin_amdgcn_readlane(__float_as_int(wvv), k0 + e));
                const bf16_t* vr = PV + (size_t)id * DM + lane * 8;
#pragma unroll
                for (int c = 0; c < 4; ++c) { const u32x4 v = *(const u32x4*)(vr + c * 512);
                    acc[c][0] += wk * bflo(v.x); acc[c][1] += wk * bfhi(v.x); acc[c][2] += wk * bflo(v.y); acc[c][3] += wk * bfhi(v.y);
                    acc[c][4] += wk * bflo(v.z); acc[c][5] += wk * bfhi(v.z); acc[c][6] += wk * bflo(v.w); acc[c][7] += wk * bfhi(v.w); } }
        } }
    const float* gt = (const float*)(p.ws + WS_MOD) + stream_of(row) * 12288 + 10240; float* xr = p.out + O_Y + (size_t)row * DM;
    float ss = 0.f;
#pragma unroll
    for (int c = 0; c < 4; ++c) { const int e = c * 512 + lane * 8;
        const f32x4 xa = *(const f32x4*)(xr + e), xb = *(const f32x4*)(xr + e + 4), ga = *(const f32x4*)(gt + e), gb = *(const f32x4*)(gt + e + 4);
#pragma unroll
        for (int j = 0; j < 4; ++j) { acc[c][j] = xa[j] + ga[j] * acc[c][j]; acc[c][4 + j] = xb[j] + gb[j] * acc[c][4 + j]; ss += acc[c][j] * acc[c][j] + acc[c][4 + j] * acc[c][4 + j]; } }
    ss = wave_sum(ss);
    const float rstd = __builtin_amdgcn_rsqf(ss * (1.0f / 2048.0f) + 1e-6f);
#pragma unroll
    for (int c = 0; c < 4; ++c) { const int e = c * 512 + lane * 8; const f32x4 fa = *(const f32x4*)(p.g_final + e), fb = *(const f32x4*)(p.g_final + e + 4);
        *(f32x4*)(xr + e) = (f32x4){acc[c][0], acc[c][1], acc[c][2], acc[c][3]} * rstd * fa; *(f32x4*)(xr + e + 4) = (f32x4){acc[c][4], acc[c][5], acc[c][6], acc[c][7]} * rstd * fb; }
}
__device__ __forceinline__ void phase_peer(const Params& p) {
    const int lane = threadIdx.x & 63, wv = threadIdx.x >> 6;
    for (int row = blockIdx.x * 8 + wv; row < MT; row += gridDim.x * 8) peer_token(p, row, lane);
}

__global__ void __launch_bounds__(512, 2) fwd_mega(Params p) {
    extern __shared__ __attribute__((aligned(16))) unsigned char smem[];
    LAS unsigned char* lds = (LAS unsigned char*)smem;
    cg::grid_group grid = cg::this_grid();
    const int lo = p.ph_lo, hi = p.ph_hi;
#define RUN(k) if (lo <= (k) && (k) < hi)
#define SEAM(k) do { if (lo < (k) && (k) < hi) grid.sync(); __syncthreads(); } while (0)
    RUN(0) { phase_prep(p, lds); }
    SEAM(1);
    RUN(1) { phase_norm(p, 0); }
    SEAM(2);
    RUN(2) { pg8::Gemm g{(const bf16_t*)(p.ws + WS_H), (const bf16_t*)(p.ws + WS_WIN), MT, IN_DIM, 2048}; pg8::StaticOrder S; S.init(MT, IN_DIM, (int)gridDim.x, (int)blockIdx.x);
        EpiIn E{p.ws, p.out}; pg8::gemm_phase<EpiIn, pg8::StaticOrder>(lds, g, S, E, nullptr); }
    SEAM(3);
    RUN(3) { phase_mixers(p, lds); }
    SEAM(4);
    RUN(4) { pg8::StaticOrder S; S.init(MT, 2048, (int)gridDim.x, (int)blockIdx.x);
        { pg8::Gemm g{(const bf16_t*)(p.ws + WS_Q), (const bf16_t*)(p.ws + WS_WA), MT, 2048, 1024}; EpiMix<0> E{(const bf16_t*)(p.ws + WS_SGA), (bf16_t*)(p.ws + WS_H)}; pg8::gemm_phase<EpiMix<0>, pg8::StaticOrder>(lds, g, S, E, nullptr); }
        __syncthreads();
        { pg8::Gemm g{(const bf16_t*)(p.ws + WS_U), (const bf16_t*)(p.ws + WS_WB), MT, 2048, 1024}; EpiMix<1> E{(const bf16_t*)(p.ws + WS_SGB), (bf16_t*)(p.ws + WS_H)}; pg8::gemm_phase<EpiMix<1>, pg8::StaticOrder>(lds, g, S, E, nullptr); } }
    SEAM(5);
    RUN(5) { pg8::Gemm g{(const bf16_t*)(p.ws + WS_H), (const bf16_t*)(p.ws + WS_WOUT), MT, 2048, 2048}; pg8::StaticOrder S; S.init(MT, 2048, (int)gridDim.x, (int)blockIdx.x);
        EpiX1 E{p.x_prompt, p.x_sample, (const float*)(p.ws + WS_MOD), p.out}; pg8::gemm_phase<EpiX1, pg8::StaticOrder>(lds, g, S, E, nullptr); }
    SEAM(6);
    RUN(6) { phase_norm(p, 1); }
    SEAM(7);
    RUN(7) { pg8::Gemm g{(const bf16_t*)(p.ws + WS_H), (const bf16_t*)(p.ws + WS_WQ), MT, 2048, 2048}; pg8::StaticOrder S; S.init(MT, 2048, (int)gridDim.x, (int)blockIdx.x);
        EpiQP E{(bf16_t*)(p.ws + WS_SGA)}; pg8::gemm_phase<EpiQP, pg8::StaticOrder>(lds, g, S, E, nullptr); }
    SEAM(8);
    RUN(8) { phase_topk(p, lds); }
    SEAM(9);
    RUN(9) { phase_peer(p); }
#ifdef DBG_COPY
    RUN(10) { const unsigned* src = (const unsigned*)(p.ws + DBG_SRC); unsigned* dst = (unsigned*)p.out;
        for (size_t i = (size_t)blockIdx.x * 512 + threadIdx.x; i < (size_t)DBG_WORDS; i += (size_t)gridDim.x * 512) dst[i] = src[i]; }
#endif
}

constexpr int N_PHASES = 10;
#ifndef N_LAUNCH_MODE
#define N_LAUNCH_MODE 0
#endif
extern "C" void kernel_launch(void* const* d_in, const int* in_sizes, int n_in, void* d_out, int out_size, void* d_ws, size_t ws_size, hipStream_t stream) {
    static int grid_blocks = 0;
    if (!grid_blocks) {
        int dev = 0, cus = 0, per_cu = 0;
        hipGetDevice(&dev);
        hipDeviceGetAttribute(&cus, hipDeviceAttributeMultiprocessorCount, dev);
        hipFuncSetAttribute((const void*)fwd_mega, hipFuncAttributeMaxDynamicSharedMemorySize, LDS_BYTES);
        hipOccupancyMaxActiveBlocksPerMultiprocessor(&per_cu, (const void*)fwd_mega, 512, LDS_BYTES);
        if (per_cu < 1) per_cu = 1;
        grid_blocks = cus * per_cu;
        if (ws_size < WS_END) { fprintf(stderr, "kernel_launch: workspace too small: %zu < %zu\n", ws_size, (size_t)WS_END); }
    }
    Params p{};
    const float* const* in = (const float* const*)d_in;
    p.x_prompt = in[0]; p.x_sample = in[1]; p.cache_k = in[2]; p.cache_v = in[3]; p.c_prompt = in[4]; p.c_sample = in[5];
    p.w_mod = in[6]; p.b_mod = in[7]; p.g_norm1 = in[8]; p.w_in = in[9]; p.sinks = in[10]; p.ln_g = in[11]; p.ln_b = in[12];
    p.gm_ws = in[13]; p.gm_b = in[14]; p.w_a = in[15]; p.w_b = in[16]; p.w_out = in[17]; p.g_norm2 = in[18]; p.pk_wq = in[19];
    p.pk_keys = in[20]; p.peer_u = in[21]; p.peer_v = in[22]; p.g_final = in[23];
    p.out = (float*)d_out; p.ws = (unsigned char*)d_ws;
#if N_LAUNCH_MODE == 1
    p.ph_lo = 0; p.ph_hi = N_PHASES;
    { void* args[] = {&p}; hipError_t e = hipLaunchCooperativeKernel((const void*)fwd_mega, dim3(grid_blocks), dim3(512), args, LDS_BYTES, stream);
      if (e != hipSuccess) fprintf(stderr, "cooperative launch failed: %s (grid %d)\n", hipGetErrorString(e), grid_blocks); }
#else
    for (int ph = 0; ph < N_PHASES; ++ph) { p.ph_lo = ph; p.ph_hi = ph + 1;
#ifdef DBG_COPY
        if (ph == N_PHASES - 1) { p.ph_lo = 10; p.ph_hi = 11; }
#endif
        void* args[] = {&p};
        hipError_t e = hipLaunchCooperativeKernel((const void*)fwd_mega, dim3(grid_blocks), dim3(512), args, LDS_BYTES, stream);
        if (e != hipSuccess) fprintf(stderr, "launch %d failed: %s (grid %d)\n", ph, hipGetErrorString(e), grid_blocks); }
#endif
}
```

```cpp
#include <hip/hip_runtime.h>
#include <hip/hip_cooperative_groups.h>
#include <cstdio>
namespace cg = cooperative_groups;
__device__ __forceinline__ int tid_fresh() { int t = (int)threadIdx.x; asm volatile("" : "+v"(t)); return t; }
namespace pg8 {
#define PG8_LAS __attribute__((address_space(3)))
typedef unsigned short bf16_t;
typedef short bf16x8 __attribute__((ext_vector_type(8)));
typedef float f32x4 __attribute__((ext_vector_type(4)));
typedef unsigned u32x4 __attribute__((ext_vector_type(4)));
constexpr int BM = 256, BK = 64, HALF = 128, HTB = HALF * BK * 2  , STAGE_BYTES = 8 * HTB, NXCD = 8, WGM = 8;

__host__ __device__ __forceinline__ int lds_byte(int r, int c) { const int st = (r >> 4) * 2 + (c >> 5), rr = r & 15, cc = c & 31, ob = rr * 64 + cc * 2; return st * 1024 + (ob ^ (((ob >> 9) & 1) << 5)); }
__host__ __device__ __forceinline__ void stage_rc(int b, int& R, int& C) { const int st = b / 1024, sb = b % 1024, swz = sb ^ (((sb >> 9) & 1) << 5); R = (st >> 1) * 16 + swz / 64; C = (st & 1) * 32 + (swz % 64) / 2; }
__host__ __device__ __forceinline__ int perm32(int rho) { const int n = rho >> 4, i = rho & 15; return 8 * (i >> 2) + 4 * n + (i & 3); }

struct Unit { int pm, pn, mask; };
struct Gemm { const bf16_t* A; const bf16_t* Bt; int M, N, K; };

struct StaticOrder {
    int nM, nN, nwg, G, c;
    __host__ __device__ void init(int M, int N, int G_, int c_) { nM = M / BM; nN = N / BM; nwg = nM * nN; G = G_; c = c_; }
    __host__ __device__ bool next(int i, Unit& u) const {
        long L = (long)i * G + c; u.mask = 15;
        { const long tail = (long)nwg - (long)i * G;
          if (tail > 0 && tail * 4 <= G) { if (c >= tail * 4) return false; L = (long)i * G + (c >> 2); u.mask = 1 << (c & 3); } }
        if (L >= nwg) return false;
        int wgid = (int)L; { const int q = nwg / NXCD, r = nwg % NXCD, xcd = wgid % NXCD, off = wgid / NXCD; wgid = (xcd < r ? xcd * (q + 1) : r * (q + 1) + (xcd - r) * q) + off; }
        const int nig = WGM * nN, gid = wgid / nig, fm = gid * WGM, gsz = (nM - fm) < WGM ? (nM - fm) : WGM;
        u.pm = fm + ((wgid % nig) % gsz); u.pn = (wgid % nig) / gsz; return true;
    }
    __device__ __forceinline__ void a_ready(const Unit&) const {}
    __device__ __forceinline__ void done(const Unit&) const {}
};
typedef __bf16 bf16pair_t __attribute__((ext_vector_type(2)));
typedef float f32pair_t __attribute__((ext_vector_type(2)));
__device__ __forceinline__ unsigned cvt_pk_bf16(float lo, float hi) { const f32pair_t v = {lo, hi}; return __builtin_bit_cast(unsigned, __builtin_convertvector(v, bf16pair_t)); }
template <class Epi, class Sched, bool STAMP = false>
__device__ __forceinline__ void gemm_phase(PG8_LAS unsigned char* lds, const Gemm g, const Sched& S, const Epi& E, unsigned long long* stamps) {
    const int tid = tid_fresh(), wid = __builtin_amdgcn_readfirstlane(tid >> 6), lane = tid & 63, wr = wid >> 2, wc = wid & 3, fr = lane & 15, fq = lane >> 4;
    const int K = g.K, nt = K / BK;
    unsigned voffA[2], voffB[2];
#pragma unroll
    for (int i = 0; i < 2; ++i) { int R, C; stage_rc(tid * 16 + i * 8192, R, C); const int Rb = Epi::PERM ? ((R & ~31) + perm32(R & 31)) : R;
        voffA[i] = (unsigned)(R * K + C) * 2u; voffB[i] = (unsigned)(Rb * K + C) * 2u; }
    const size_t kstep = (size_t)(BK * 2);
    const size_t hstep = (size_t)HALF * K * 2;
    const size_t tstep = 2 * hstep;
    const unsigned ldsw = (unsigned)wid * 1024u;
    const int aoff = lds_byte(wr * 64 + fr, fq * 8), boff = lds_byte(wc * 32 + fr, fq * 8);
#define PG8_SA(b, h) (((b) * 2 + (h)) * HTB)
#define PG8_SB(b, h) ((4 + (b) * 2 + (h)) * HTB)
#define PG8_STAGE(bufoff, gbase, voff) do { _Pragma("unroll") for (int _i = 0; _i < 2; ++_i) \
        __builtin_amdgcn_global_load_lds((const unsigned*)((const char*)(gbase) + (voff)[_i]), (PG8_LAS unsigned*)(lds + (bufoff) + ldsw + _i * 8192), 16, 0, 0); } while (0)
#define PG8_LDA(dst, b, h) do { _Pragma("unroll") for (int m = 0; m < 4; ++m) _Pragma("unroll") for (int k = 0; k < 2; ++k) dst[m][k] = *(const PG8_LAS bf16x8*)(lds + PG8_SA(b, h) + aoff + m * 2048 + k * 1024); } while (0)
#define PG8_LDB(dst, b, h) do { _Pragma("unroll") for (int n = 0; n < 2; ++n) _Pragma("unroll") for (int k = 0; k < 2; ++k) dst[n][k] = *(const PG8_LAS bf16x8*)(lds + PG8_SB(b, h) + boff + n * 2048 + k * 1024); } while (0)
#define PG8_MMA(ai, bj, At, Bt) do { __builtin_amdgcn_s_setprio(1); _Pragma("unroll") for (int m = 0; m < 4; ++m) _Pragma("unroll") for (int n = 0; n < 2; ++n) _Pragma("unroll") for (int k = 0; k < 2; ++k) \
        acc[ai][bj][m][n] = __builtin_amdgcn_mfma_f32_16x16x32_bf16(Bt[n][k], At[m][k], acc[ai][bj][m][n], 0, 0, 0); __builtin_amdgcn_s_setprio(0); } while (0)
#define PG8_MMAQ(ai, bj, At, Bt) do { if (cmask & (1 << ((ai) * 2 + (bj)))) { __builtin_amdgcn_s_setprio(1); _Pragma("unroll") for (int m = 0; m < 4; ++m) _Pragma("unroll") for (int n = 0; n < 2; ++n) _Pragma("unroll") for (int k = 0; k < 2; ++k) \
        acc[ai][bj][m][n] = __builtin_amdgcn_mfma_f32_16x16x32_bf16(Bt[n][k], At[m][k], acc[ai][bj][m][n], 0, 0, 0); __builtin_amdgcn_s_setprio(0); } } while (0)
#define PG8_WAIT_V(n) asm volatile("s_waitcnt vmcnt(" #n ")" ::: "memory")
#define PG8_WAIT_L(n) asm volatile("s_waitcnt lgkmcnt(" #n ")" ::: "memory")
#define PG8_BAR __builtin_amdgcn_s_barrier()
#define PG8_SCHED __builtin_amdgcn_sched_barrier(0)
    Unit cur, nxt; int ui = 0;
    if (!S.next(0, cur)) return;
    int cmask = cur.mask;
    f32x4 acc[2][2][4][2];
#pragma unroll
    for (int a = 0; a < 2; ++a)
#pragma unroll
        for (int b = 0; b < 2; ++b)
#pragma unroll
            for (int m = 0; m < 4; ++m)
#pragma unroll
                for (int n = 0; n < 2; ++n) acc[a][b][m][n] = (f32x4){0.f, 0.f, 0.f, 0.f};
    bf16x8 At[4][2], B0[2][2], B1[2][2];
    const char* cA = (const char*)g.A + (size_t)cur.pm * tstep; const char* cB = (const char*)g.Bt + (size_t)cur.pn * tstep;
    S.a_ready(cur);
    PG8_STAGE(PG8_SB(0, 0), cB, voffB); PG8_STAGE(PG8_SA(0, 0), cA, voffA); PG8_STAGE(PG8_SB(0, 1), cB + hstep, voffB); PG8_STAGE(PG8_SA(0, 1), cA + hstep, voffA);
    if (wr == 1) PG8_BAR;
    PG8_WAIT_V(4); PG8_BAR;
    PG8_STAGE(PG8_SB(1, 0), cB + kstep, voffB); PG8_STAGE(PG8_SA(1, 0), cA + kstep, voffA); PG8_STAGE(PG8_SB(1, 1), cB + hstep + kstep, voffB);
    PG8_WAIT_V(6); PG8_BAR;
    for (;;) {
        const bool has_next = S.next(ui + 1, nxt);
        const char* nA = has_next ? (const char*)g.A + (size_t)nxt.pm * tstep : cA; const char* nB = has_next ? (const char*)g.Bt + (size_t)nxt.pn * tstep : cB;
        if (cmask == 15) {
        for (int t = 0; t < nt; t += 2) {
            if constexpr (Epi::HAS_MID) { if (t == (nt >> 1)) E.mid(acc, cur, wr, wc, fr, fq); }
            const bool last = (t == nt - 2);
            const char* a1 = cA + (size_t)(t + 1) * kstep;
            const char* a2 = last ? nA : cA + (size_t)(t + 2) * kstep; const char* b2 = last ? nB : cB + (size_t)(t + 2) * kstep;
            const char* a3 = a2 + kstep; const char* b3 = b2 + kstep;
            if (last && has_next) S.a_ready(nxt);
            PG8_LDB(B0, 0, 0); PG8_SCHED; PG8_LDA(At, 0, 0); PG8_STAGE(PG8_SA(1, 1), a1 + hstep, voffA);
            PG8_WAIT_L(8); PG8_BAR; PG8_WAIT_L(0); PG8_MMA(0, 0, At, B0); PG8_BAR; PG8_SCHED;
            PG8_LDB(B1, 0, 1); PG8_STAGE(PG8_SB(0, 0), b2, voffB);
            PG8_BAR; PG8_WAIT_L(0); PG8_MMA(0, 1, At, B1); PG8_BAR;
            PG8_LDA(At, 0, 1); PG8_STAGE(PG8_SA(0, 0), a2, voffA);
            PG8_BAR; PG8_WAIT_L(0); PG8_MMA(1, 0, At, B0); PG8_BAR; PG8_SCHED;
            PG8_STAGE(PG8_SB(0, 1), b2 + hstep, voffB);
            PG8_WAIT_V(6); PG8_BAR; PG8_MMA(1, 1, At, B1); PG8_BAR;
            PG8_LDB(B0, 1, 0); PG8_SCHED; PG8_LDA(At, 1, 0); PG8_STAGE(PG8_SA(0, 1), a2 + hstep, voffA);
            PG8_WAIT_L(8); PG8_BAR; PG8_WAIT_L(0); PG8_MMA(0, 0, At, B0); PG8_BAR; PG8_SCHED;
            PG8_LDB(B1, 1, 1); PG8_STAGE(PG8_SB(1, 0), b3, voffB);
            PG8_BAR; PG8_WAIT_L(0); PG8_MMA(0, 1, At, B1); PG8_BAR;
            PG8_LDA(At, 1, 1); PG8_STAGE(PG8_SA(1, 0), a3, voffA);
            PG8_BAR; PG8_WAIT_L(0); PG8_MMA(1, 0, At, B0); PG8_BAR; PG8_SCHED;
            PG8_STAGE(PG8_SB(1, 1), b3 + hstep, voffB);
            PG8_WAIT_V(6); PG8_BAR; PG8_MMA(1, 1, At, B1); PG8_BAR;
        }
        } else {
        for (int t = 0; t < nt; t += 2) {
            if constexpr (Epi::HAS_MID) { if (t == (nt >> 1)) E.mid(acc, cur, wr, wc, fr, fq); }
            const bool last = (t == nt - 2);
            const char* a1 = cA + (size_t)(t + 1) * kstep;
            const char* a2 = last ? nA : cA + (size_t)(t + 2) * kstep; const char* b2 = last ? nB : cB + (size_t)(t + 2) * kstep;
            const char* a3 = a2 + kstep; const char* b3 = b2 + kstep;
            if (last && has_next) S.a_ready(nxt);
            PG8_LDB(B0, 0, 0); PG8_SCHED; PG8_LDA(At, 0, 0); PG8_STAGE(PG8_SA(1, 1), a1 + hstep, voffA);
            PG8_WAIT_L(8); PG8_BAR; PG8_WAIT_L(0); PG8_MMAQ(0, 0, At, B0); PG8_BAR; PG8_SCHED;
            PG8_LDB(B1, 0, 1); PG8_STAGE(PG8_SB(0, 0), b2, voffB);
            PG8_BAR; PG8_WAIT_L(0); PG8_MMAQ(0, 1, At, B1); PG8_BAR;
            PG8_LDA(At, 0, 1); PG8_STAGE(PG8_SA(0, 0), a2, voffA);
            PG8_BAR; PG8_WAIT_L(0); PG8_MMAQ(1, 0, At, B0); PG8_BAR; PG8_SCHED;
            PG8_STAGE(PG8_SB(0, 1), b2 + hstep, voffB);
            PG8_WAIT_V(6); PG8_BAR; PG8_MMAQ(1, 1, At, B1); PG8_BAR;
            PG8_LDB(B0, 1, 0); PG8_SCHED; PG8_LDA(At, 1, 0); PG8_STAGE(PG8_SA(0, 1), a2 + hstep, voffA);
            PG8_WAIT_L(8); PG8_BAR; PG8_WAIT_L(0); PG8_MMAQ(0, 0, At, B0); PG8_BAR; PG8_SCHED;
            PG8_LDB(B1, 1, 1); PG8_STAGE(PG8_SB(1, 0), b3, voffB);
            PG8_BAR; PG8_WAIT_L(0); PG8_MMAQ(0, 1, At, B1); PG8_BAR;
            PG8_LDA(At, 1, 1); PG8_STAGE(PG8_SA(1, 0), a3, voffA);
            PG8_BAR; PG8_WAIT_L(0); PG8_MMAQ(1, 0, At, B0); PG8_BAR; PG8_SCHED;
            PG8_STAGE(PG8_SB(1, 1), b3 + hstep, voffB);
            PG8_WAIT_V(6); PG8_BAR; PG8_MMAQ(1, 1, At, B1); PG8_BAR;
        }
        }
        if constexpr (!Epi::AFTER_DRAIN) { E(acc, cur, wr, wc, fr, fq); S.done(cur); }
        if (!has_next) break;
#pragma unroll
        for (int a = 0; a < 2; ++a)
#pragma unroll
            for (int b = 0; b < 2; ++b)
#pragma unroll
                for (int m = 0; m < 4; ++m)
#pragma unroll
                    for (int n = 0; n < 2; ++n) acc[a][b][m][n] = (f32x4){0.f, 0.f, 0.f, 0.f};
        cur = nxt; cmask = cur.mask; cA = nA; cB = nB; ++ui;
    }
    PG8_WAIT_V(0);
    if (wr == 0) PG8_BAR;
    PG8_BAR;
    if constexpr (Epi::AFTER_DRAIN) { E.fused(acc, cur, wr, wc, fr, fq, lds, wid, lane); S.done(cur); }
#undef PG8_SA
#undef PG8_SB
#undef PG8_STAGE
#undef PG8_LDA
#undef PG8_LDB
#undef PG8_MMA
#undef PG8_MMAQ
#undef PG8_WAIT_V
#undef PG8_WAIT_L
#undef PG8_BAR
#undef PG8_SCHED
}
}

#define LAS __attribute__((address_space(3)))
typedef unsigned short bf16_t;
typedef short bf16x8 __attribute__((ext_vector_type(8)));
typedef float f32x4 __attribute__((ext_vector_type(4)));
typedef float f32x2 __attribute__((ext_vector_type(2)));
typedef unsigned u32x4 __attribute__((ext_vector_type(4)));
typedef unsigned u32x2 __attribute__((ext_vector_type(2)));
typedef int i32x4 __attribute__((ext_vector_type(4)));

constexpr int DM = 2048, MP = 16384, MS = 512, MT = MP + MS;
constexpr int IN_DIM = 7680;
constexpr int NEXP = 16384;
constexpr int LDS_BYTES = 149 * 1024;

constexpr size_t WS_WIN = 0;
constexpr size_t WS_WA = WS_WIN + (size_t)IN_DIM * DM * 2;
constexpr size_t WS_WB = WS_WA + (size_t)2048 * 1024 * 2;
constexpr size_t WS_WOUT = WS_WB + (size_t)2048 * 1024 * 2;
constexpr size_t WS_WQ = WS_WOUT + (size_t)2048 * 2048 * 2;
constexpr size_t WS_KEYS = WS_WQ + (size_t)2048 * 2048 * 2;
constexpr size_t WS_WM = WS_KEYS + (size_t)262144 * 2;
constexpr size_t WS_PU = WS_WM + (size_t)131072 * 2;
constexpr size_t WS_PV = WS_PU + (size_t)NEXP * DM * 2;
constexpr size_t WS_MOD = WS_PV + (size_t)NEXP * DM * 2;
constexpr size_t WS_H = WS_MOD + (size_t)17 * 12288 * 4;
constexpr size_t WS_Q = WS_H + (size_t)MT * 2048 * 2;
constexpr size_t WS_KB = WS_Q + (size_t)MT * 1024 * 2;
constexpr size_t WS_VB = WS_KB + (size_t)MT * 256 * 2;
constexpr size_t WS_U = WS_VB + (size_t)MT * 256 * 2;
constexpr size_t WS_GV = WS_U + (size_t)MT * 1024 * 2;
constexpr size_t WS_SGA = WS_GV + (size_t)MT * 1024 * 2;
constexpr size_t WS_SGB = WS_SGA + (size_t)MT * 2048 * 2;
constexpr size_t WS_END = WS_SGB + (size_t)MT * 2048 * 2;
constexpr size_t WS_SU = WS_END + 1024, WS_SV = WS_SU + 65536;
constexpr size_t WS_BAR = WS_SV + 65536;
constexpr size_t WS_EID = WS_GV;
constexpr size_t WS_GW = WS_GV + (size_t)MT * 128 * 4;
constexpr size_t WS_T = WS_SGB;

constexpr size_t O_Y = 0, O_KP = (size_t)MT * DM, O_VP = O_KP + 32768, O_KS = O_VP + 32768, O_VS = O_KS + 131072, O_GVS = O_VS + 131072;

struct Params {
    const float* x_prompt; const float* x_sample; const float* cache_k; const float* cache_v; const float* c_prompt; const float* c_sample;
    const float* w_mod; const float* b_mod; const float* g_norm1; const float* w_in; const float* sinks; const float* ln_g; const float* ln_b;
    const float* gm_ws; const float* gm_b; const float* w_a; const float* w_b; const float* w_out; const float* g_norm2; const float* pk_wq;
    const float* pk_keys; const float* peer_u; const float* peer_v; const float* g_final;
    float* out; unsigned char* ws; int ph_lo, ph_hi;
};

__device__ __forceinline__ float bf2f(unsigned short b) { return __uint_as_float(((unsigned)b) << 16); }
__device__ __forceinline__ float bflo(unsigned w) { return __uint_as_float(w << 16); }
__device__ __forceinline__ float bfhi(unsigned w) { return __uint_as_float(w & 0xffff0000u); }
using pg8::cvt_pk_bf16;
__device__ __forceinline__ float fast_exp(float x) { return __builtin_amdgcn_exp2f(x * 1.4426950408889634f); }
__device__ __forceinline__ float sigmoidf_(float x) { return __builtin_amdgcn_rcpf(1.0f + fast_exp(-x)); }
__device__ __forceinline__ float gelu_tanh(float x) { const float t = 1.5957691216057308f * (x + 0.044715f * x * x * x); return x * sigmoidf_(t); }
__device__ __forceinline__ float wave_sum(float v) {
#pragma unroll
    for (int o = 32; o >= 1; o >>= 1) v += __shfl_xor(v, o);
    return v;
}
__device__ __forceinline__ const float* xrow_ptr(const Params& p, int row) { return row < MP ? p.x_prompt + (size_t)row * DM : p.x_sample + (size_t)(row - MP) * DM; }
__device__ __forceinline__ int stream_of(int row) { return row < MP ? 0 : 1 + ((row - MP) >> 5); }

#define XB_TMO      128
#define XB_XCNT(j)  (256  + 64 * (j))
#define XB_XSUB(j)  (1280 + 64 * (j))
#define XB_XGEN(j)  (2304 + 64 * (j))
#define XB_TOP      3328
#define XB_TOPGEN   3392
#define XCD_BAR_WORDS 3456
#define XB_SPIN_CAP (1u << 18)

__device__ __forceinline__ unsigned xb_ld(unsigned* p)              { return __hip_atomic_load(p, __ATOMIC_RELAXED, __HIP_MEMORY_SCOPE_AGENT); }
__device__ __forceinline__ unsigned xb_add(unsigned* p, unsigned v) { return __hip_atomic_fetch_add(p, v, __ATOMIC_RELAXED, __HIP_MEMORY_SCOPE_AGENT); }
__device__ __forceinline__ unsigned xb_xcc_id() { return (unsigned)__builtin_amdgcn_s_getreg((3 << 11) | 20) & 0xFu; }
#define XB_SPIN(cond, bar) do { unsigned _sp = 0; while (cond) { __builtin_amdgcn_s_sleep(1); \
    if ((++_sp & 255u) == 0u) { if (xb_ld(&(bar)[XB_TMO])) break; if (_sp > XB_SPIN_CAP) { atomicAdd(&(bar)[XB_TMO], 1u); break; } } } } while (0)

struct XcdBarrier {
    unsigned* bar; unsigned x;
    volatile LAS unsigned* st;
};

__device__ __forceinline__ XcdBarrier xcd_barrier_post(unsigned* bar, volatile LAS unsigned* st) {
    XcdBarrier b; b.bar = bar; b.x = xb_xcc_id(); b.st = st;
    if (tid_fresh() == 0) (void)xb_add(&bar[XB_XCNT(b.x)], 1u);
    return b;
}
__device__ __forceinline__ void xcd_barrier_complete(unsigned* bar, unsigned x, unsigned& nloc, unsigned& nx) {
    const unsigned G = gridDim.x * gridDim.y * gridDim.z;
    unsigned sum, cnt, mine, sp = 0u;
    for (;;) {
        sum = 0u; cnt = 0u; mine = 0u;
#pragma unroll
        for (unsigned j = 0; j < 16; ++j) { const unsigned c = xb_ld(&bar[XB_XCNT(j)]); sum += c; cnt += (c > 0u) ? 1u : 0u; mine = (j == x) ? c : mine; }
        if (sum == G) break;
        __builtin_amdgcn_s_sleep(1);
        if ((++sp & 255u) == 0u) { if (xb_ld(&bar[XB_TMO])) break; if (sp > XB_SPIN_CAP) { atomicAdd(&bar[XB_TMO], 1u); break; } }
    }
    nloc = mine > 0u ? mine : 1u; nx = cnt > 0u ? cnt : 1u;
}

__device__ __forceinline__ void xcd_barrier(const XcdBarrier& b) {
    asm volatile("s_waitcnt vmcnt(0)" ::: "memory");
    __syncthreads();
    if (tid_fresh() == 0) {
        unsigned* bar = b.bar;
        __builtin_amdgcn_s_waitcnt(0);
        unsigned nloc = b.st[0], nx = b.st[1];
        if (nloc == 0u) { xcd_barrier_complete(bar, b.x, nloc, nx); b.st[0] = nloc; b.st[1] = nx; }
        const unsigned old = xb_add(&bar[XB_XSUB(b.x)], 1u);
        const unsigned gen = old / nloc;
        if (old + 1u == (gen + 1u) * nloc) {
            __builtin_amdgcn_fence(__ATOMIC_RELEASE, "agent");
            asm volatile("s_waitcnt vmcnt(0)" ::: "memory");
            const unsigned og = xb_add(&bar[XB_TOP], 1u);
            const unsigned tg = og / nx;
            if (og + 1u == (tg + 1u) * nx) xb_add(&bar[XB_TOPGEN], 1u);
            else XB_SPIN(xb_ld(&bar[XB_TOPGEN]) == tg, bar);
            __builtin_amdgcn_fence(__ATOMIC_ACQUIRE, "agent");
            xb_add(&bar[XB_XGEN(b.x)], 1u);
            asm volatile("s_waitcnt vmcnt(0)" ::: "memory");
        } else {
            XB_SPIN(xb_ld(&bar[XB_XGEN(b.x)]) == gen, bar);
            __builtin_amdgcn_fence(__ATOMIC_ACQUIRE, "agent");
            asm volatile("s_waitcnt vmcnt(0)" ::: "memory");
        }
    }
    __syncthreads();
}


constexpr int P0_MOD = 192, P0_TR_WIN = 32 * 30, P0_TR_WA = 16 * 8, P0_TR_WO = 32 * 8;
constexpr int P0_TR0 = P0_MOD, P0_TR1 = P0_TR0 + P0_TR_WIN, P0_TR2 = P0_TR1 + P0_TR_WA, P0_TR3 = P0_TR2 + P0_TR_WA, P0_TR4 = P0_TR3 + P0_TR_WO, P0_TR5 = P0_TR4 + P0_TR_WO;
constexpr int P0_CV2 = P0_TR1, P0_CV3 = P0_CV2 + 32, P0_END = P0_CV3 + 16;

__device__ __forceinline__ void prep_transpose(LAS unsigned char* lds, const float* __restrict__ W, bf16_t* __restrict__ Wt, int K, int N, int tile, int ldk) {
    LAS float* T = (LAS float*)lds;
    const int tn = N / 256; const int k0 = (tile / tn) * 64, n0 = (tile % tn) * 256; const int t = tid_fresh();
    float v[32];
#pragma unroll
    for (int i = 0; i < 32; ++i) v[i] = W[(size_t)(k0 + i * 2 + (t >> 8)) * N + n0 + (t & 255)];
#pragma unroll
    for (int i = 0; i < 32; ++i) T[(i * 2 + (t >> 8)) * 257 + (t & 255)] = v[i];
    __syncthreads();
#pragma unroll
    for (int i = 0; i < 16; ++i) { const int nn = i * 16 + (t >> 5), kk = (t & 31) * 2;
        const unsigned w = cvt_pk_bf16(T[kk * 257 + nn], T[(kk + 1) * 257 + nn]);
        *(unsigned*)(Wt + (size_t)(n0 + nn) * ldk + k0 + kk) = w; }
    __syncthreads();
}
__device__ __forceinline__ void prep_convert(const float* __restrict__ src, bf16_t* __restrict__ dst, int unit, bool mask_gm) {
    const size_t e0 = (size_t)unit * 8192 + (size_t)tid_fresh() * 8;
#pragma unroll
    for (int j = 0; j < 2; ++j) { const size_t e = e0 + (size_t)j * 4096;
        f32x4 a = *(const f32x4*)(src + e), b = *(const f32x4*)(src + e + 4);
        if (mask_gm) { const int i = (int)((e >> 7) & 127), jj = (int)(e & 127); if ((jj >> 6) > (i >> 6)) { a = (f32x4){0.f, 0.f, 0.f, 0.f}; b = a; } }
        u32x4 w; w.x = cvt_pk_bf16(a[0], a[1]); w.y = cvt_pk_bf16(a[2], a[3]); w.z = cvt_pk_bf16(b[0], b[1]); w.w = cvt_pk_bf16(b[2], b[3]);
        *(u32x4*)(dst + e) = w; }
}
typedef int v6i_t __attribute__((ext_vector_type(6)));
typedef float v32f_t __attribute__((ext_vector_type(32)));
typedef float v16f_t __attribute__((ext_vector_type(16)));
constexpr int PROW = 1536;
constexpr int PSEG = 192;
__device__ __forceinline__ void prep_quant(const float* __restrict__ src, unsigned char* __restrict__ dst, float* __restrict__ scales, int unit, bool sliced) {
    const int lane = tid_fresh() & 63, wv = tid_fresh() >> 6; const int row = unit * 8 + wv;
    const float* r = src + (size_t)row * 2048;
    f32x4 v[8]; float mx = 0.f;
#pragma unroll
    for (int j = 0; j < 8; ++j) { v[j] = *(const f32x4*)(r + j * 256 + lane * 4); mx = fmaxf(mx, fmaxf(fmaxf(fabsf(v[j][0]), fabsf(v[j][1])), fmaxf(fabsf(v[j][2]), fabsf(v[j][3])))); }
#pragma unroll
    for (int o = 32; o >= 1; o >>= 1) mx = fmaxf(mx, __shfl_xor(mx, o));
    const float sc = mx > 0.f ? mx * (1.0f / 7.5f) : 1.0f, inv = mx > 0.f ? 7.5f / mx : 0.f;
    typedef _Float16 v32h_t __attribute__((ext_vector_type(32)));
    v32h_t x;
#pragma unroll
    for (int j = 0; j < 8; ++j)
#pragma unroll
        for (int i = 0; i < 4; ++i) x[4 * j + i] = (_Float16)fminf(fmaxf(v[j][i] * inv, -7.5f), 7.5f);
    const v6i_t w = __builtin_amdgcn_cvt_scalef32_pk32_fp6_f16(x, 1.0f);
    unsigned char* d = sliced ? dst + (size_t)(lane >> 3) * ((size_t)NEXP * PSEG) + (size_t)row * PSEG + 24 * (lane & 7) : dst + (size_t)row * PROW + 24 * lane;
    *(u32x2*)d = (u32x2){(unsigned)w[0], (unsigned)w[1]}; *(u32x2*)(d + 8) = (u32x2){(unsigned)w[2], (unsigned)w[3]}; *(u32x2*)(d + 16) = (u32x2){(unsigned)w[4], (unsigned)w[5]};
    if (lane == 0) scales[row] = sc;
}
__device__ __forceinline__ void prep_mod(const Params& p, LAS unsigned char* lds, int unit) {
    LAS float* SC = (LAS float*)lds;
    const int t = tid_fresh();
    for (int i = t; i < 17 * 2048; i += 512) { const int r = i >> 11, k = i & 2047; const float c = r == 0 ? p.c_prompt[k] : p.c_sample[(r - 1) * 2048 + k]; SC[i] = c * sigmoidf_(c); }
    __syncthreads();
    const int cgp = t & 15, ks = t >> 4; const int n0 = unit * 64 + cgp * 4;
    f32x4 acc[17];
#pragma unroll
    for (int r = 0; r < 17; ++r) acc[r] = (f32x4){0.f, 0.f, 0.f, 0.f};
    const float* wp = p.w_mod + (size_t)(ks * 64) * 12288 + n0;
    for (int k4 = 0; k4 < 64; k4 += 4) {
        f32x4 w0 = *(const f32x4*)(wp + (size_t)(k4 + 0) * 12288), w1 = *(const f32x4*)(wp + (size_t)(k4 + 1) * 12288), w2 = *(const f32x4*)(wp + (size_t)(k4 + 2) * 12288), w3 = *(const f32x4*)(wp + (size_t)(k4 + 3) * 12288);
#pragma unroll
        for (int r = 0; r < 17; ++r) { const f32x4 s = *(const LAS f32x4*)(SC + r * 2048 + ks * 64 + k4);
            acc[r] += w0 * s[0]; acc[r] += w1 * s[1]; acc[r] += w2 * s[2]; acc[r] += w3 * s[3]; }
    }
#pragma unroll
    for (int r = 0; r < 17; ++r)
#pragma unroll
        for (int j = 0; j < 4; ++j) { float v = acc[r][j]; v += __shfl_xor(v, 16); v += __shfl_xor(v, 32); acc[r][j] = v; }
    __syncthreads();
    LAS float* R = (LAS float*)lds;
    const int wv = t >> 6, lane = t & 63;
    if (lane < 16) {
#pragma unroll
        for (int r = 0; r < 17; ++r) *(LAS f32x4*)(R + (wv * 17 + r) * 64 + lane * 4) = acc[r]; }
    __syncthreads();
    float* MOD = (float*)(p.ws + WS_MOD);
    for (int i = t; i < 17 * 64; i += 512) { const int r = i >> 6, c = i & 63; float s = 0.f;
#pragma unroll
        for (int w = 0; w < 8; ++w) s += R[(w * 17 + r) * 64 + c];
        MOD[r * 12288 + unit * 64 + c] = s + p.b_mod[unit * 64 + c]; }
    __syncthreads();
}
__device__ __forceinline__ void phase_prep(const Params& p, LAS unsigned char* lds) {
    const int G = (int)gridDim.x, b = (int)blockIdx.x, nshort = P0_END - P0_MOD;
    if (G <= P0_MOD) { for (int u = b; u < P0_END; u += G) {
            if (u < P0_MOD) prep_mod(p, lds, u);
            else if (u < P0_TR1) prep_transpose(lds, p.w_in, (bf16_t*)(p.ws + WS_WIN), 2048, IN_DIM, u - P0_TR0, 2048);
            else if (u < P0_CV3) prep_convert(p.pk_keys, (bf16_t*)(p.ws + WS_KEYS), u - P0_CV2, false);
            else prep_convert(p.gm_ws, (bf16_t*)(p.ws + WS_WM), u - P0_CV3, true); }
        return; }
    const int NA = (nshort * 51) / 100;
    int lo, hi, step, first;
    if (b < P0_MOD) { prep_mod(p, lds, b); lo = 0; hi = NA; step = P0_MOD; first = b; } else { lo = NA; hi = nshort; step = G - P0_MOD; first = NA + (b - P0_MOD); }
    for (int v = first; v < hi; v += step) { const int u = P0_MOD + v;
        if (u < P0_TR1) prep_transpose(lds, p.w_in, (bf16_t*)(p.ws + WS_WIN), 2048, IN_DIM, u - P0_TR0, 2048);
        else if (u < P0_CV3) prep_convert(p.pk_keys, (bf16_t*)(p.ws + WS_KEYS), u - P0_CV2, false);
        else prep_convert(p.gm_ws, (bf16_t*)(p.ws + WS_WM), u - P0_CV3, true); }
    (void)lo;
}

__device__ __forceinline__ void tail_quant(const Params& p, int u_lo, int u_hi, int n_units_gemm) {
    const int G = (int)gridDim.x, tail = n_units_gemm % G, busy = (tail * 4 <= G) ? tail * 4 : tail, nidle = G - busy;
    if ((int)blockIdx.x >= busy) { for (int u = u_lo + (int)blockIdx.x - busy; u < u_hi; u += nidle) {
        if (u < NEXP / 8) prep_quant(p.peer_u, p.ws + WS_PU, (float*)(p.ws + WS_SU), u, true); else prep_quant(p.peer_v, p.ws + WS_PV, (float*)(p.ws + WS_SV), u - NEXP / 8, false); } }
}

__device__ __forceinline__ void tail_transpose(LAS unsigned char* lds, const float* __restrict__ W, bf16_t* __restrict__ Wt, int K, int N, int ldk, int n_tiles, int n_units_gemm) {
    const int G = (int)gridDim.x, tail = n_units_gemm % G, busy = (tail * 4 <= G) ? tail * 4 : tail, nidle = G - busy;
    if ((int)blockIdx.x >= busy) { for (int u = (int)blockIdx.x - busy; u < n_tiles; u += nidle) prep_transpose(lds, W, Wt, K, N, u, ldk); }
}

__device__ __forceinline__ void phase_norm(const Params& p, int which) {
    const int lane = tid_fresh() & 63, wv = tid_fresh() >> 6;
    const float* MOD = (const float*)(p.ws + WS_MOD);
    const float* gn = which ? p.g_norm2 : p.g_norm1;
    const int sh_off = which ? 6144 : 0, sc_off = which ? 8192 : 2048;
    bf16_t* H = (bf16_t*)(p.ws + WS_H);
    int cur_s = -1; f32x4 mul[8], add[8];
    const int stride = gridDim.x * 8;
    for (int row = blockIdx.x * 8 + wv; row < MT; row += 2 * stride) {
        const int row1 = row + stride; const bool has1 = row1 < MT;
        const float* xr0 = xrow_ptr(p, row); const float* xr1 = has1 ? xrow_ptr(p, row1) : xr0;
        f32x4 v0[8], v1[8];
#pragma unroll
        for (int j = 0; j < 8; ++j) { v0[j] = *(const f32x4*)(xr0 + j * 256 + lane * 4); v1[j] = *(const f32x4*)(xr1 + j * 256 + lane * 4); }
        if (which) {
            const bf16_t* T = (const bf16_t*)(p.ws + WS_T); const bf16_t* t0 = T + (size_t)row * DM; const bf16_t* t1 = T + (size_t)(has1 ? row1 : row) * DM;
#pragma unroll
            for (int j = 0; j < 8; ++j) { const u32x2 a = *(const u32x2*)(t0 + j * 256 + lane * 4), b = *(const u32x2*)(t1 + j * 256 + lane * 4);
                v0[j] += (f32x4){bflo(a.x), bfhi(a.x), bflo(a.y), bfhi(a.y)}; v1[j] += (f32x4){bflo(b.x), bfhi(b.x), bflo(b.y), bfhi(b.y)}; } }
#pragma unroll
        for (int rr = 0; rr < 2; ++rr) {
            if (rr == 1 && !has1) break;
            const int r = rr ? row1 : row; const int sidx = stream_of(r);
            if (sidx != cur_s) { cur_s = sidx;
#pragma unroll
                for (int j = 0; j < 8; ++j) { const int e = j * 256 + lane * 4; const f32x4 g = *(const f32x4*)(gn + e), sc = *(const f32x4*)(MOD + sidx * 12288 + sc_off + e), sh = *(const f32x4*)(MOD + sidx * 12288 + sh_off + e);
                    mul[j] = g * (sc + 1.0f); add[j] = sh; } }
            float ss = 0.f;
#pragma unroll
            for (int j = 0; j < 8; ++j) { const f32x4 x = rr ? v1[j] : v0[j]; ss += x[0] * x[0] + x[1] * x[1] + x[2] * x[2] + x[3] * x[3]; }
            ss = wave_sum(ss);
            const float rstd = __builtin_amdgcn_rsqf(ss * (1.0f / 2048.0f) + 1e-6f);
#pragma unroll
            for (int j = 0; j < 8; ++j) { const f32x4 x = rr ? v1[j] : v0[j]; const f32x4 o = x * rstd * mul[j] + add[j]; u32x2 w; w.x = cvt_pk_bf16(o[0], o[1]); w.y = cvt_pk_bf16(o[2], o[3]);
                *(u32x2*)(H + (size_t)r * DM + j * 256 + lane * 4) = w; }
        }
    }
}

__device__ __forceinline__ size_t gate_off(int pm, int pnq, int wave, int frag, int lane) { return ((((size_t)(pm * 8 + pnq) * 8 + wave) * 16 + frag) * 64 + lane) * 8; }
struct EpiIn {
    static constexpr bool PERM = true, AFTER_DRAIN = false, HAS_MID = false;
    unsigned char* ws; float* out;
    __device__ __forceinline__ void operator()(const f32x4 (&acc)[2][2][4][2], const pg8::Unit& u, int wr, int wc, int fr, int fq) const {
        const int pn = u.pn; bf16_t* base; int ldc, colt, act;
        if (pn < 4) { base = (bf16_t*)(ws + WS_Q); ldc = 1024; colt = pn * 256; act = 0; }
        else if (pn == 4) { base = (bf16_t*)(ws + WS_KB); ldc = 256; colt = 0; act = 0; }
        else if (pn == 5) { base = (bf16_t*)(ws + WS_VB); ldc = 256; colt = 0; act = 0; }
        else if (pn < 10) { base = (bf16_t*)(ws + WS_U); ldc = 1024; colt = (pn - 6) * 256; act = 1; }
        else if (pn < 14) { base = (bf16_t*)(ws + WS_GV); ldc = 1024; colt = (pn - 10) * 256; act = 1; }
        else if (pn < 22) { base = (bf16_t*)(ws + WS_SGA); ldc = 2048; colt = (pn - 14) * 256; act = 2; }
        else { base = (bf16_t*)(ws + WS_SGB); ldc = 2048; colt = (pn - 22) * 256; act = 2; }
        const int row0 = u.pm * 256 + wr * 64 + fr, col0 = colt + wc * 32 + 8 * fq;
        const bool kv = (pn == 4 || pn == 5);
#pragma unroll
        for (int ai = 0; ai < 2; ++ai)
#pragma unroll
            for (int m = 0; m < 4; ++m) { const int row = row0 + ai * 128 + m * 16; bf16_t* rowp = base + (size_t)row * ldc + col0;
#pragma unroll
                for (int bj = 0; bj < 2; ++bj) { if (!((u.mask >> (ai * 2 + bj)) & 1)) continue; f32x4 v0 = acc[ai][bj][m][0], v1 = acc[ai][bj][m][1];
                    if (act == 1) {
#pragma unroll
                        for (int j = 0; j < 4; ++j) { v0[j] = gelu_tanh(v0[j]); v1[j] = gelu_tanh(v1[j]); } }
                    else if (act == 2) {
#pragma unroll
                        for (int j = 0; j < 4; ++j) { v0[j] = sigmoidf_(v0[j]); v1[j] = sigmoidf_(v1[j]); } }
                    if (kv && row >= MP - 128) {
                        float* o = out + (pn == 4 ? (row < MP ? O_KP : O_KS) : (row < MP ? O_VP : O_VS)) + (size_t)(row < MP ? row - (MP - 128) : row - MP) * 256 + col0 + bj * 128;
                        *(f32x4*)o = v0; *(f32x4*)(o + 4) = v1; }
                    u32x4 w; w.x = cvt_pk_bf16(v0[0], v0[1]); w.y = cvt_pk_bf16(v0[2], v0[3]); w.z = cvt_pk_bf16(v1[0], v1[1]); w.w = cvt_pk_bf16(v1[2], v1[3]);
                    if (act == 2) *(u32x4*)(base + gate_off(u.pm, (pn - 14) & 7, wr * 4 + wc, ai * 8 + m * 2 + bj, fq * 16 + fr)) = w;
                    else *(u32x4*)(rowp + bj * 128) = w; } }
    }
};
struct EpiMixF {
    static constexpr bool PERM = true, AFTER_DRAIN = false, HAS_MID = true;
    const bf16_t* sga; const bf16_t* sgb; bf16_t* mix;
    __device__ __forceinline__ void mid(f32x4 (&acc)[2][2][4][2], const pg8::Unit& u, int wr, int wc, int fr, int fq) const {
        const unsigned base = (unsigned)(gate_off(u.pm, u.pn, wr * 4 + wc, 0, fq * 16 + fr) * 2);
        u32x4 na[2], nb[2];
        { unsigned o = base; asm volatile("" : "+v"(o)); const char* pa = (const char*)sga + o; const char* pb = (const char*)sgb + o;
          na[0] = *(const u32x4*)pa; na[1] = *(const u32x4*)(pa + 1024); nb[0] = *(const u32x4*)pb; nb[1] = *(const u32x4*)(pb + 1024); }
#pragma unroll
        for (int st = 0; st < 8; ++st) { const int ai = st >> 2, m = st & 3;
            u32x4 ca[2] = {na[0], na[1]}, cb[2] = {nb[0], nb[1]};
            if (st < 7) { unsigned o = base + (unsigned)((st + 1) * 2048);
                asm volatile("" : "+v"(o));
                const char* pa = (const char*)sga + o; const char* pb = (const char*)sgb + o;
                na[0] = *(const u32x4*)pa; na[1] = *(const u32x4*)(pa + 1024); nb[0] = *(const u32x4*)pb; nb[1] = *(const u32x4*)(pb + 1024); }
#pragma unroll
            for (int bj = 0; bj < 2; ++bj) { if (!((u.mask >> (ai * 2 + bj)) & 1)) continue; const u32x4 ga = ca[bj], gb = cb[bj];
                f32x4 r0, r1;
                r0[0] = bflo(ga.x) * __builtin_amdgcn_rcpf(fmaxf(bflo(gb.x), 1e-30f)); r0[1] = bfhi(ga.x) * __builtin_amdgcn_rcpf(fmaxf(bfhi(gb.x), 1e-30f));
                r0[2] = bflo(ga.y) * __builtin_amdgcn_rcpf(fmaxf(bflo(gb.y), 1e-30f)); r0[3] = bfhi(ga.y) * __builtin_amdgcn_rcpf(fmaxf(bfhi(gb.y), 1e-30f));
                r1[0] = bflo(ga.z) * __builtin_amdgcn_rcpf(fmaxf(bflo(gb.z), 1e-30f)); r1[1] = bfhi(ga.z) * __builtin_amdgcn_rcpf(fmaxf(bfhi(gb.z), 1e-30f));
                r1[2] = bflo(ga.w) * __builtin_amdgcn_rcpf(fmaxf(bflo(gb.w), 1e-30f)); r1[3] = bfhi(ga.w) * __builtin_amdgcn_rcpf(fmaxf(bfhi(gb.w), 1e-30f));
                acc[ai][bj][m][0] *= r0; acc[ai][bj][m][1] *= r1; }
            asm volatile("" ::: "memory"); }
    }
    __device__ __forceinline__ void operator()(const f32x4 (&acc)[2][2][4][2], const pg8::Unit& u, int wr, int wc, int fr, int fq) const {
        const int row0 = u.pm * 256 + wr * 64 + fr, col0 = u.pn * 256 + wc * 32 + 8 * fq;
#pragma unroll
        for (int ai = 0; ai < 2; ++ai)
#pragma unroll
            for (int m = 0; m < 4; ++m) { const size_t off = (size_t)(row0 + ai * 128 + m * 16) * 2048 + col0;
#pragma unroll
                for (int bj = 0; bj < 2; ++bj) { if (!((u.mask >> (ai * 2 + bj)) & 1)) continue; const u32x4 g = *(const u32x4*)(sgb + gate_off(u.pm, u.pn, wr * 4 + wc, ai * 8 + m * 2 + bj, fq * 16 + fr)); const f32x4 a0 = acc[ai][bj][m][0], a1 = acc[ai][bj][m][1];
                    u32x4 w; w.x = cvt_pk_bf16(bflo(g.x) * a0[0], bfhi(g.x) * a0[1]); w.y = cvt_pk_bf16(bflo(g.y) * a0[2], bfhi(g.y) * a0[3]); w.z = cvt_pk_bf16(bflo(g.z) * a1[0], bfhi(g.z) * a1[1]); w.w = cvt_pk_bf16(bflo(g.w) * a1[2], bfhi(g.w) * a1[3]);
                    *(u32x4*)(mix + off + bj * 128) = w; } }
    }
};
struct EpiT {
    static constexpr bool PERM = true, AFTER_DRAIN = false, HAS_MID = false;
    const float* MOD; bf16_t* T;
    __device__ __forceinline__ void operator()(const f32x4 (&acc)[2][2][4][2], const pg8::Unit& u, int wr, int wc, int fr, int fq) const {
        const int row0 = u.pm * 256 + wr * 64 + fr, col0 = u.pn * 256 + wc * 32 + 8 * fq;
        if (u.pm < MP / 256) {
            const float* gt = MOD + 4096 + col0; f32x4 g[2][2];
#pragma unroll
            for (int bj = 0; bj < 2; ++bj) { g[bj][0] = *(const f32x4*)(gt + bj * 128); g[bj][1] = *(const f32x4*)(gt + bj * 128 + 4); }
#pragma unroll
            for (int ai = 0; ai < 2; ++ai)
#pragma unroll
                for (int m = 0; m < 4; ++m) { bf16_t* rowp = T + (size_t)(row0 + ai * 128 + m * 16) * 2048 + col0;
#pragma unroll
                    for (int bj = 0; bj < 2; ++bj) { if (!((u.mask >> (ai * 2 + bj)) & 1)) continue; const f32x4 v0 = acc[ai][bj][m][0] * g[bj][0], v1 = acc[ai][bj][m][1] * g[bj][1];
                        u32x4 w; w.x = cvt_pk_bf16(v0[0], v0[1]); w.y = cvt_pk_bf16(v0[2], v0[3]); w.z = cvt_pk_bf16(v1[0], v1[1]); w.w = cvt_pk_bf16(v1[2], v1[3]);
                        *(u32x4*)(rowp + bj * 128) = w; } }
        } else {
#pragma unroll
            for (int ai = 0; ai < 2; ++ai)
#pragma unroll
                for (int m = 0; m < 4; ++m) { const int row = row0 + ai * 128 + m * 16; const float* gt = MOD + stream_of(row) * 12288 + 4096 + col0; bf16_t* rowp = T + (size_t)row * 2048 + col0;
#pragma unroll
                    for (int bj = 0; bj < 2; ++bj) { if (!((u.mask >> (ai * 2 + bj)) & 1)) continue; const f32x4 v0 = acc[ai][bj][m][0] * *(const f32x4*)(gt + bj * 128), v1 = acc[ai][bj][m][1] * *(const f32x4*)(gt + bj * 128 + 4);
                        u32x4 w; w.x = cvt_pk_bf16(v0[0], v0[1]); w.y = cvt_pk_bf16(v0[2], v0[3]); w.z = cvt_pk_bf16(v1[0], v1[1]); w.w = cvt_pk_bf16(v1[2], v1[3]);
                        *(u32x4*)(rowp + bj * 128) = w; } }
        }
    }
};
struct EpiQP {
    static constexpr bool PERM = true, AFTER_DRAIN = false, HAS_MID = false;
    bf16_t* qp;
    __device__ __forceinline__ void operator()(const f32x4 (&acc)[2][2][4][2], const pg8::Unit& u, int wr, int wc, int fr, int fq) const {
        const int row0 = u.pm * 256 + wr * 64 + fr, col0 = u.pn * 256 + wc * 32 + 8 * fq;
#pragma unroll
        for (int ai = 0; ai < 2; ++ai)
#pragma unroll
            for (int m = 0; m < 4; ++m) { bf16_t* rowp = qp + (size_t)(row0 + ai * 128 + m * 16) * 2048 + col0;
#pragma unroll
                for (int bj = 0; bj < 2; ++bj) { if (!((u.mask >> (ai * 2 + bj)) & 1)) continue; const f32x4 v0 = acc[ai][bj][m][0], v1 = acc[ai][bj][m][1];
                    u32x4 w; w.x = cvt_pk_bf16(v0[0], v0[1]); w.y = cvt_pk_bf16(v0[2], v0[3]); w.z = cvt_pk_bf16(v1[0], v1[1]); w.w = cvt_pk_bf16(v1[2], v1[3]);
                    *(u32x4*)(rowp + bj * 128) = w; } }
    }
};
#define MFMA16(a, b, c) __builtin_amdgcn_mfma_f32_16x16x32_bf16((a), (b), (c), 0, 0, 0)
constexpr int ATT_KS = 72, ATT_VS = 200;
constexpr int N_ATT_P = 1024, N_ATT_S = 64, N_GM_P = 1024, N_GM_S = 128, N_MIX_ITEMS = N_ATT_P + N_ATT_S + N_GM_P + N_GM_S;

__device__ __forceinline__ void attn_item(const Params& p, LAS unsigned char* lds, int item) {
    LAS bf16_t* Ks = (LAS bf16_t*)lds;
    LAS bf16_t* Vt = (LAS bf16_t*)(lds + 192 * ATT_KS * 2);
    const int t = tid_fresh(), lane = t & 63, wv = t >> 6, n = lane & 15, q = lane >> 4;
    const bf16_t* KB = (const bf16_t*)(p.ws + WS_KB); const bf16_t* VB = (const bf16_t*)(p.ws + WS_VB);
    bf16_t* Q = (bf16_t*)(p.ws + WS_Q); bf16_t* OAB = (bf16_t*)(p.ws + WS_H);
    int kvh, tok0, nq, kv_lo, kv_hi, chunk = 0, sb = 0; const bool samp = item >= N_ATT_P;
    if (!samp) { chunk = item >> 2; kvh = item & 3; tok0 = chunk * 64; nq = 64; kv_lo = chunk >= 2 ? 0 : (chunk == 1 ? 64 : 128); kv_hi = 192; }
    else { const int it = item - N_ATT_P; sb = it >> 2; kvh = it & 3; tok0 = MP + sb * 32; nq = 32; kv_lo = 0; kv_hi = 160; }
#pragma unroll
    for (int i = 0; i < 3; ++i) { const int pr = t + i * 512, key = pr >> 3, seg = pr & 7;
        u32x4 kw = (u32x4){0u, 0u, 0u, 0u}, vw = kw;
        if (key >= kv_lo && key < kv_hi) {
            if (!samp) { const size_t r = (size_t)((chunk - 2) * 64 + key); kw = *(const u32x4*)(KB + r * 256 + kvh * 64 + seg * 8); vw = *(const u32x4*)(VB + r * 256 + kvh * 64 + seg * 8); }
            else if (key >= 128) { const size_t r = (size_t)(MP + sb * 32 + key - 128); kw = *(const u32x4*)(KB + r * 256 + kvh * 64 + seg * 8); vw = *(const u32x4*)(VB + r * 256 + kvh * 64 + seg * 8); }
            else { const size_t o = ((size_t)(sb * 128 + key) * 4 + kvh) * 64 + seg * 8;
                const f32x4 a = *(const f32x4*)(p.cache_k + o), b = *(const f32x4*)(p.cache_k + o + 4), c = *(const f32x4*)(p.cache_v + o), d = *(const f32x4*)(p.cache_v + o + 4);
                kw.x = cvt_pk_bf16(a[0], a[1]); kw.y = cvt_pk_bf16(a[2], a[3]); kw.z = cvt_pk_bf16(b[0], b[1]); kw.w = cvt_pk_bf16(b[2], b[3]);
                vw.x = cvt_pk_bf16(c[0], c[1]); vw.y = cvt_pk_bf16(c[2], c[3]); vw.z = cvt_pk_bf16(d[0], d[1]); vw.w = cvt_pk_bf16(d[2], d[3]); } }
        *(LAS u32x4*)(Ks + key * ATT_KS + seg * 8) = kw;
        const int kin = key & 31, pos = (key & ~31) + 8 * ((kin >> 2) & 3) + 4 * (kin >> 4) + (kin & 3);
        const int possw = (pos & ~63) | ((((pos >> 3) & 7) ^ seg) << 3) | (pos & 7);
        LAS bf16_t* vp = Vt + (seg * 8) * ATT_VS + possw;
        vp[0 * ATT_VS] = (bf16_t)(vw.x & 0xffff); vp[1 * ATT_VS] = (bf16_t)(vw.x >> 16); vp[2 * ATT_VS] = (bf16_t)(vw.y & 0xffff); vp[3 * ATT_VS] = (bf16_t)(vw.y >> 16);
        vp[4 * ATT_VS] = (bf16_t)(vw.z & 0xffff); vp[5 * ATT_VS] = (bf16_t)(vw.z >> 16); vp[6 * ATT_VS] = (bf16_t)(vw.w & 0xffff); vp[7 * ATT_VS] = (bf16_t)(vw.w >> 16); }
    __syncthreads();
    const int g = wv >> 1, half = wv & 1, h = kvh * 4 + g;
    if (half * 32 < nq) {
        const int qrow0 = tok0 + half * 32;
        bf16x8 Qf[2][2];
#pragma unroll
        for (int qb = 0; qb < 2; ++qb)
#pragma unroll
            for (int s = 0; s < 2; ++s) Qf[qb][s] = *(const bf16x8*)(Q + (size_t)(qrow0 + qb * 16 + n) * 1024 + h * 64 + s * 32 + q * 8);
        f32x4 S[12][2];
#pragma unroll
        for (int kb = 0; kb < 12; ++kb) {
            const bf16x8 a0 = *(const LAS bf16x8*)(Ks + (kb * 16 + n) * ATT_KS + q * 8), a1 = *(const LAS bf16x8*)(Ks + (kb * 16 + n) * ATT_KS + 32 + q * 8);
#pragma unroll
            for (int qb = 0; qb < 2; ++qb) { f32x4 c = (f32x4){0.f, 0.f, 0.f, 0.f}; c = MFMA16(a0, Qf[qb][0], c); c = MFMA16(a1, Qf[qb][1], c); S[kb][qb] = c; } }
        const float sink = p.sinks[h];
        bf16x8 Pf[6][2];
#pragma unroll
        for (int qb = 0; qb < 2; ++qb) {
            float mx = sink;
#pragma unroll
            for (int kb = 0; kb < 12; ++kb)
#pragma unroll
                for (int j = 0; j < 4; ++j) { const int key = kb * 16 + 4 * q + j; const bool ok = key >= kv_lo && key < kv_hi; const float s = ok ? S[kb][qb][j] * 0.125f : -1e30f; S[kb][qb][j] = s; mx = fmaxf(mx, s); }
            mx = fmaxf(mx, __shfl_xor(mx, 16)); mx = fmaxf(mx, __shfl_xor(mx, 32));
            float sum = 0.f;
#pragma unroll
            for (int kb = 0; kb < 12; ++kb)
#pragma unroll
                for (int j = 0; j < 4; ++j) { const float e = fast_exp(S[kb][qb][j] - mx); S[kb][qb][j] = e; sum += e; }
            sum += __shfl_xor(sum, 16); sum += __shfl_xor(sum, 32);
            const float inv = 1.0f / (sum + fast_exp(sink - mx));
#pragma unroll
            for (int kp = 0; kp < 6; ++kp) { const f32x4 a = S[2 * kp][qb] * inv, b = S[2 * kp + 1][qb] * inv;
                u32x4 w; w.x = cvt_pk_bf16(a[0], a[1]); w.y = cvt_pk_bf16(a[2], a[3]); w.z = cvt_pk_bf16(b[0], b[1]); w.w = cvt_pk_bf16(b[2], b[3]);
                Pf[kp][qb] = __builtin_bit_cast(bf16x8, w); }
        }
#pragma unroll
        for (int db = 0; db < 4; ++db) {
            f32x4 o0 = (f32x4){0.f, 0.f, 0.f, 0.f}, o1 = o0;
#pragma unroll
            for (int kp = 0; kp < 6; ++kp) { const int pb = kp * 4 + q; const bf16x8 a = *(const LAS bf16x8*)(Vt + (db * 16 + n) * ATT_VS + (((pb & ~7) | ((pb & 7) ^ ((2 * db + (n >> 3)) & 7))) << 3)); o0 = MFMA16(a, Pf[kp][0], o0); o1 = MFMA16(a, Pf[kp][1], o1); }
            u32x2 w0, w1; w0.x = cvt_pk_bf16(o0[0], o0[1]); w0.y = cvt_pk_bf16(o0[2], o0[3]); w1.x = cvt_pk_bf16(o1[0], o1[1]); w1.y = cvt_pk_bf16(o1[2], o1[3]);
            *(u32x2*)(OAB + (size_t)(qrow0 + n) * 2048 + h * 64 + db * 16 + 4 * q) = w0;
            *(u32x2*)(OAB + (size_t)(qrow0 + 16 + n) * 2048 + h * 64 + db * 16 + 4 * q) = w1; }
    }
    __syncthreads();
}

constexpr int GM_S = 136;
__device__ __forceinline__ void gmlp_item(const Params& p, LAS unsigned char* lds, int item) {
    LAS bf16_t* VgT = (LAS bf16_t*)lds;
    LAS bf16_t* WmS = (LAS bf16_t*)(lds + 128 * GM_S * 2);
    LAS float* ST = (LAS float*)(lds + 2 * 128 * GM_S * 2);
    const int t = tid_fresh(), lane = t & 63, wv = t >> 6, n = lane & 15, q = lane >> 4;
    const bf16_t* GV = (const bf16_t*)(p.ws + WS_GV); bf16_t* U = (bf16_t*)(p.ws + WS_U); const bf16_t* WM = (const bf16_t*)(p.ws + WS_WM);
    int g, tok0, ntok, sb = 0; const bool samp = item >= N_GM_P;
    if (!samp) { g = item & 7; tok0 = (item >> 3) * 128; ntok = 128; } else { const int it = item - N_GM_P; g = it & 7; sb = it >> 3; tok0 = MP + sb * 32; ntok = 32; }
    if (wv * 16 < ntok) {
        const bool b0 = lane & 1, b1 = lane & 2, b2 = lane & 4;
#pragma unroll 1
        for (int i4 = 0; i4 < 16; i4 += 4) {
            u32x4 ra[4], rb[4];
#pragma unroll
            for (int i = 0; i < 4; ++i) { const bf16_t* r = GV + (size_t)(tok0 + wv * 16 + i4 + i) * 1024 + lane * 8; ra[i] = *(const u32x4*)r; rb[i] = *(const u32x4*)(r + 512); }
            float pr[8];
#pragma unroll
            for (int i = 0; i < 4; ++i) {
                const float v[16] = {bflo(ra[i].x), bfhi(ra[i].x), bflo(ra[i].y), bfhi(ra[i].y), bflo(ra[i].z), bfhi(ra[i].z), bflo(ra[i].w), bfhi(ra[i].w), bflo(rb[i].x), bfhi(rb[i].x), bflo(rb[i].y), bfhi(rb[i].y), bflo(rb[i].z), bfhi(rb[i].z), bflo(rb[i].w), bfhi(rb[i].w)};
                float sm = 0.f, sq = 0.f;
#pragma unroll
                for (int e = 0; e < 16; ++e) { sm += v[e]; sq += v[e] * v[e]; }
                pr[i] = sm; pr[4 + i] = sq; }
            float r4[4], s2[2];
#pragma unroll
            for (int i = 0; i < 4; ++i) r4[i] = (b0 ? pr[4 + i] : pr[i]) + __shfl_xor(b0 ? pr[i] : pr[4 + i], 1);
#pragma unroll
            for (int i = 0; i < 2; ++i) s2[i] = (b1 ? r4[2 + i] : r4[i]) + __shfl_xor(b1 ? r4[i] : r4[2 + i], 2);
            float tt = (b2 ? s2[1] : s2[0]) + __shfl_xor(b2 ? s2[0] : s2[1], 4);
            tt += __shfl_xor(tt, 8); tt += __shfl_xor(tt, 16); tt += __shfl_xor(tt, 32);
            const float other = __shfl_xor(tt, 1);
            if (lane < 8 && !b0) { const float sm = tt, sq = other; const int j = wv * 16 + i4 + ((lane >> 1) & 1) * 2 + ((lane >> 2) & 1);
                const float mean = sm * (1.0f / 1024.0f), var = fmaxf(sq * (1.0f / 1024.0f) - mean * mean, 0.f);
                ST[j * 2] = mean; ST[j * 2 + 1] = __builtin_amdgcn_rsqf(var + 1e-6f); }
        }
    }
#pragma unroll
    for (int i = 0; i < 4; ++i) { const int c = t + i * 512, row = c >> 4, sg = c & 15; *(LAS u32x4*)(WmS + row * GM_S + sg * 8) = *(const u32x4*)(WM + (size_t)g * 16384 + row * 128 + sg * 8); }
    __syncthreads();
    { const int sg = (t & 15) * 8; f32x4 lg0 = *(const f32x4*)(p.ln_g + g * 128 + sg), lg1 = *(const f32x4*)(p.ln_g + g * 128 + sg + 4), lb0 = *(const f32x4*)(p.ln_b + g * 128 + sg), lb1 = *(const f32x4*)(p.ln_b + g * 128 + sg + 4);
#pragma unroll
        for (int it = 0; it < 4; ++it) { const int j = (t >> 4) + 32 * it; float o[8];
            if (j < ntok) { const u32x4 a = *(const u32x4*)(GV + (size_t)(tok0 + j) * 1024 + g * 128 + sg); const float mean = ST[j * 2], rstd = ST[j * 2 + 1];
                const float v[8] = {bflo(a.x), bfhi(a.x), bflo(a.y), bfhi(a.y), bflo(a.z), bfhi(a.z), bflo(a.w), bfhi(a.w)};
#pragma unroll
                for (int e = 0; e < 8; ++e) o[e] = (v[e] - mean) * rstd * (e < 4 ? lg0[e & 3] : lg1[e & 3]) + (e < 4 ? lb0[e & 3] : lb1[e & 3]);
                if (samp) { float* d = p.out + O_GVS + (size_t)(sb * 32 + j) * 1024 + g * 128 + sg; *(f32x4*)d = (f32x4){o[0], o[1], o[2], o[3]}; *(f32x4*)(d + 4) = (f32x4){o[4], o[5], o[6], o[7]}; } }
            else {
#pragma unroll
                for (int e = 0; e < 8; ++e) o[e] = 0.f; }
#pragma unroll
            for (int e = 0; e < 8; e += 2) { const unsigned w = cvt_pk_bf16(o[e], o[e + 1]); const int jsw = (((j >> 3) ^ ((sg >> 3) & 15)) << 3) | (j & 7);
                VgT[(sg + e) * GM_S + jsw] = (bf16_t)(w & 0xffff); VgT[(sg + e + 1) * GM_S + jsw] = (bf16_t)(w >> 16); } } }
    __syncthreads();
    if (wv * 16 < ntok) {
        const int i = wv * 16 + n; bf16x8 Bf[4];
#pragma unroll
        for (int ks = 0; ks < 4; ++ks) Bf[ks] = *(const LAS bf16x8*)(WmS + i * GM_S + ks * 32 + q * 8);
        const float bias = p.gm_b[g * 128 + i];
#pragma unroll
        for (int cb = 0; cb < 8; ++cb) { f32x4 c = (f32x4){0.f, 0.f, 0.f, 0.f};
#pragma unroll
            for (int ks = 0; ks < 4; ++ks) { const bf16x8 a = *(const LAS bf16x8*)(VgT + (cb * 16 + n) * GM_S + (((ks * 4 + q) ^ ((2 * cb + (n >> 3)) & 15)) << 3)); c = MFMA16(a, Bf[ks], c); }
            bf16_t* up = U + (size_t)(tok0 + i) * 1024 + g * 128 + cb * 16 + 4 * q; const u32x2 uw = *(const u32x2*)up;
            u32x2 w; w.x = cvt_pk_bf16(bflo(uw.x) * (c[0] + bias), bfhi(uw.x) * (c[1] + bias)); w.y = cvt_pk_bf16(bflo(uw.y) * (c[2] + bias), bfhi(uw.y) * (c[3] + bias));
            *(u32x2*)((bf16_t*)(p.ws + WS_H) + (size_t)(tok0 + i) * 2048 + 1024 + g * 128 + cb * 16 + 4 * q) = w; }
    }
    __syncthreads();
}
__device__ __forceinline__ void phase_mixers(const Params& p, LAS unsigned char* lds) {
    for (int it = blockIdx.x; it < N_MIX_ITEMS; it += gridDim.x) {
        if (it < N_ATT_P + N_ATT_S) attn_item(p, lds, it); else gmlp_item(p, lds, it - (N_ATT_P + N_ATT_S));
    }
}

constexpr int TK_KS = 136, TK_QS = 264, TK_SS = 129;
constexpr int TK_OFF_Q = 2 * 128 * TK_KS * 2;
constexpr int TK_OFF_L = TK_OFF_Q + 128 * TK_SS * 4;
static_assert(TK_OFF_L + 128 * 2 * 16 * 4 <= LDS_BYTES, "top-k LDS map");
__device__ __forceinline__ int f2key(float f) { const int b = __float_as_int(f); return b ^ ((b >> 31) & 0x7fffffff); }
__device__ __forceinline__ float key2f(int k) { return __int_as_float(k ^ ((k >> 31) & 0x7fffffff)); }
#define CE_DESC(a, b) do { const int _hi = max((a), (b)), _lo = min((a), (b)); (a) = _hi; (b) = _lo; } while (0)
__device__ __forceinline__ void bubble16(int (&a)[16], int v) {
#pragma unroll
    for (int j = 0; j < 16; ++j) { const int hi = max(a[j], v); v = min(a[j], v); a[j] = hi; }
}
__device__ __forceinline__ void merge16(int (&a)[16], const int (&o)[16]) {
#pragma unroll
    for (int j = 0; j < 16; ++j) a[j] = max(a[j], o[15 - j]);
#pragma unroll
    for (int d = 8; d >= 1; d >>= 1)
#pragma unroll
        for (int j = 0; j < 16; ++j) if ((j & d) == 0) CE_DESC(a[j], a[j + d]);
}
__device__ __forceinline__ void topk_item(const Params& p, LAS unsigned char* lds, int item, bool load_keys) {
    LAS bf16_t* KS = (LAS bf16_t*)lds;
    LAS bf16_t* QS = (LAS bf16_t*)(lds + TK_OFF_Q);
    LAS float* SC = (LAS float*)(lds + TK_OFF_Q);
    LAS int* LX = (LAS int*)(lds + TK_OFF_L);
    LAS int* C4 = (LAS int*)(lds + TK_OFF_Q);
    const int t = tid_fresh(), lane = t & 63, wv = t >> 6, n = lane & 15, q = lane >> 4;
    const int h = item & 7, tok0 = (item >> 3) * 64;
    const bf16_t* KEYS = (const bf16_t*)(p.ws + WS_KEYS) + (size_t)h * 32768; const bf16_t* QP = (const bf16_t*)(p.ws + WS_SGA);
    if (load_keys) {
#pragma unroll
        for (int i = 0; i < 8; ++i) { const int c = t + i * 512, row = c >> 4, sg = c & 15; *(LAS u32x4*)(KS + row * TK_KS + sg * 8) = *(const u32x4*)(KEYS + (size_t)row * 128 + sg * 8); } }
#pragma unroll
    for (int i = 0; i < 4; ++i) { const int c = t + i * 512, row = c >> 5, sg = c & 31; *(LAS u32x4*)(QS + row * TK_QS + sg * 8) = *(const u32x4*)(QP + (size_t)(tok0 + row) * 2048 + h * 256 + sg * 8); }
    __syncthreads();
    const int pp = wv >> 2, nb0 = (wv & 3) * 2;
    f32x4 acc[2][4];
#pragma unroll
    for (int a = 0; a < 2; ++a)
#pragma unroll
        for (int b = 0; b < 4; ++b) acc[a][b] = (f32x4){0.f, 0.f, 0.f, 0.f};
#pragma unroll
    for (int ks = 0; ks < 4; ++ks) {
        bf16x8 Af[2], Bq[4];
#pragma unroll
        for (int a = 0; a < 2; ++a) Af[a] = *(const LAS bf16x8*)(KS + (pp * 128 + (nb0 + a) * 16 + n) * TK_KS + ks * 32 + q * 8);
#pragma unroll
        for (int b = 0; b < 4; ++b) Bq[b] = *(const LAS bf16x8*)(QS + (b * 16 + n) * TK_QS + pp * 128 + ks * 32 + q * 8);
#pragma unroll
        for (int a = 0; a < 2; ++a)
#pragma unroll
            for (int b = 0; b < 4; ++b) acc[a][b] = MFMA16(Af[a], Bq[b], acc[a][b]);
    }
    __syncthreads();
#pragma unroll
    for (int a = 0; a < 2; ++a)
#pragma unroll
        for (int b = 0; b < 4; ++b) { LAS float* d = SC + (pp * 64 + b * 16 + n) * TK_SS + (nb0 + a) * 16 + 4 * q;
            d[0] = acc[a][b][0]; d[1] = acc[a][b][1]; d[2] = acc[a][b][2]; d[3] = acc[a][b][3]; }
    __syncthreads();
    const int inst = t & 127, part = t >> 7;
    int a[16];
    { const LAS float* src = SC + inst * TK_SS + part * 32;
        int v[32];
#pragma unroll
        for (int i = 0; i < 32; ++i) v[i] = (f2key(src[i]) & ~127) | (part * 32 + i);
#pragma unroll
        for (int k = 2; k <= 32; k <<= 1)
#pragma unroll
            for (int j = k >> 1; j >= 1; j >>= 1)
#pragma unroll
                for (int i = 0; i < 32; ++i) { const int l = i ^ j;
                    if (l > i && !(k == 32 && j < 16 && i >= 16)) {
                        if ((i & k) == 0) { CE_DESC(v[i], v[l]); } else { const int hi_ = max(v[i], v[l]), lo_ = min(v[i], v[l]); v[i] = lo_; v[l] = hi_; } } }
#pragma unroll
        for (int j = 0; j < 16; ++j) a[j] = v[j]; }
    if (part & 1) {
#pragma unroll
        for (int j = 0; j < 16; ++j) LX[(inst * 2 + (part >> 1)) * 16 + j] = a[j]; }
    __syncthreads();
    if ((part & 1) == 0) { int o[16];
#pragma unroll
        for (int j = 0; j < 16; ++j) o[j] = LX[(inst * 2 + (part >> 1)) * 16 + j];
        merge16(a, o);
        if (part == 2) {
#pragma unroll
            for (int j = 0; j < 16; ++j) LX[(inst * 2 + 1) * 16 + j] = a[j]; } }
    __syncthreads();
    if (part == 0) { int o[16];
#pragma unroll
        for (int j = 0; j < 16; ++j) o[j] = LX[(inst * 2 + 1) * 16 + j];
        merge16(a, o);
#pragma unroll
        for (int j = 0; j < 16; ++j) LX[(inst * 2) * 16 + j] = a[j]; }
    __syncthreads();
    int b[16];
#pragma unroll
    for (int j = 0; j < 16; ++j) b[j] = (int)0x80000000;
    const int tk = t & 63, cp = (t >> 6) & 3;
    const LAS int* L0 = LX + tk * 32; const LAS int* L1 = LX + (64 + tk) * 32;
    if (t < 256) {
        float f1[16];
#pragma unroll
        for (int j = 0; j < 16; ++j) f1[j] = key2f(L1[j] & ~127);
#pragma unroll
        for (int ii = 0; ii < 4; ++ii) { const int i = cp + 4 * ii; const float f0 = key2f(L0[i] & ~127);
            const int jmax = ii == 0 ? 16 : (ii == 1 ? 3 : 1);
#pragma unroll
            for (int j = 0; j < jmax; ++j) { const bool ok = (i + 1) * (j + 1) <= 16; const int key = ok ? ((f2key(f0 + f1[j]) & ~255) | (i * 16 + j)) : (int)0x80000000; bubble16(b, key); } }
        if (cp) {
#pragma unroll
            for (int j = 0; j < 16; ++j) C4[(tk * 4 + cp) * 16 + j] = b[j]; }
    }
    __syncthreads();
    if (t < 256 && (cp & 1) == 0) { int o[16];
#pragma unroll
        for (int j = 0; j < 16; ++j) o[j] = C4[(tk * 4 + cp + 1) * 16 + j];
        merge16(b, o);
        if (cp == 2) {
#pragma unroll
            for (int j = 0; j < 16; ++j) C4[(tk * 4 + 2) * 16 + j] = b[j]; } }
    __syncthreads();
    if (t < 64) { int o[16];
#pragma unroll
        for (int j = 0; j < 16; ++j) o[j] = C4[(tk * 4 + 2) * 16 + j];
        merge16(b, o);
        float cv[16], e[16]; float sum = 0.f;
#pragma unroll
        for (int k = 0; k < 16; ++k) cv[k] = key2f(b[k] & ~255);
#pragma unroll
        for (int k = 0; k < 16; ++k) { e[k] = fast_exp(cv[k] - cv[0]); sum += e[k]; }
        const float inv = 1.0f / sum;
        int* EID = (int*)(p.ws + WS_EID) + (size_t)(tok0 + tk) * 128 + h * 16; float* GW = (float*)(p.ws + WS_GW) + (size_t)(tok0 + tk) * 128 + h * 16;
#pragma unroll
        for (int k4 = 0; k4 < 4; ++k4) { i32x4 ev; f32x4 gv;
#pragma unroll
            for (int kk = 0; kk < 4; ++kk) { const int k = k4 * 4 + kk, code = b[k] & 255; const int i1 = L0[code >> 4] & 127, i2 = L1[code & 15] & 127; ev[kk] = i1 * 128 + i2; gv[kk] = e[k] * inv; }
            *(i32x4*)(EID + k4 * 4) = ev; *(f32x4*)(GW + k4 * 4) = gv; }
    }
    __syncthreads();
}
__device__ __forceinline__ void phase_topk(const Params& p, LAS unsigned char* lds) {
    int cur_h = -1;
    for (int it = blockIdx.x; it < (MT / 64) * 8; it += gridDim.x) { const int h = it & 7; topk_item(p, lds, it, h != cur_h); cur_h = h; }
}

#define BITREV3(e) ((((e) & 1) << 2) | ((e) & 2) | (((e) >> 2) & 1))
__device__ __forceinline__ float rl_f(float v, int l) { return __int_as_float(__builtin_amdgcn_readlane(__float_as_int(v), l)); }
constexpr size_t WS_PA = WS_SGA;
__device__ __forceinline__ void phase_peer_u(const Params& p) {
    const int tid_ = tid_fresh();
    const int lane = tid_ & 63, wv = __builtin_amdgcn_readfirstlane(tid_ >> 6), x = (int)blockIdx.x & 7, g = lane >> 3, jp = lane & 7, L = 8 * x + jp;
    const int nbx = ((int)gridDim.x - x + 7) >> 3, nslots = nbx * 8, wslot = ((int)blockIdx.x >> 3) * 8 + wv;
    const bf16_t* H2 = (const bf16_t*)(p.ws + WS_H); const int* EIDb = (const int*)(p.ws + WS_EID); float* PA = (float*)(p.ws + WS_PA);
    const unsigned char* PUs = p.ws + WS_PU + (size_t)x * ((size_t)NEXP * PSEG) + 24 * jp;
    if (wslot >= MT) return;
    const int nrows = (MT - wslot + nslots - 1) / nslots;
    const bool b0 = lane & 1, b1 = lane & 2, b2 = lane & 4;
    const int kst = (((jp & 1) << 2) | (jp & 2) | ((jp >> 2) & 1)) * 8 + g;
#define PU_LOAD(QA, QB, QC, EV) do { _Pragma("unroll") for (int it = 0; it < 8; ++it) { const int id = __shfl((EV), it * 8 + g); const unsigned char* ur = PUs + (size_t)id * PSEG; \
        QA[it] = *(const u32x2*)ur; QB[it] = *(const u32x2*)(ur + 8); QC[it] = *(const u32x2*)(ur + 16); } } while (0)
#define PU_DOT(QA, QB, QC, R) do { float pr[8]; _Pragma("unroll") for (int it = 0; it < 8; ++it) { const v6i_t d = {(int)QA[it].x, (int)QA[it].y, (int)QB[it].x, (int)QB[it].y, (int)QC[it].x, (int)QC[it].y}; \
        const v32f_t f = __builtin_amdgcn_cvt_scalef32_pk32_f32_fp6(d, 1.0f); f32x2 s0 = (f32x2){0.f, 0.f}, s1 = s0, s2 = s0, s3 = s0; \
        _Pragma("unroll") for (int i = 0; i < 16; i += 4) { s0 += (f32x2){f[2 * i], f[2 * i + 1]} * hv[i]; s1 += (f32x2){f[2 * i + 2], f[2 * i + 3]} * hv[i + 1]; \
            s2 += (f32x2){f[2 * i + 4], f[2 * i + 5]} * hv[i + 2]; s3 += (f32x2){f[2 * i + 6], f[2 * i + 7]} * hv[i + 3]; } \
        const f32x2 sacc = (s0 + s1) + (s2 + s3); pr[it] = sacc.x + sacc.y; \
        if (it & 1) __builtin_amdgcn_sched_barrier(0); } \
        float r4[4], s2_[2]; \
        _Pragma("unroll") for (int i = 0; i < 4; ++i) r4[i] = (b0 ? pr[4 + i] : pr[i]) + __shfl_xor(b0 ? pr[i] : pr[4 + i], 1); \
        _Pragma("unroll") for (int i = 0; i < 2; ++i) s2_[i] = (b1 ? r4[2 + i] : r4[i]) + __shfl_xor(b1 ? r4[i] : r4[2 + i], 2); \
        R = (b2 ? s2_[1] : s2_[0]) + __shfl_xor(b2 ? s2_[0] : s2_[1], 4); } while (0)
    int row = wslot;
    int e0 = EIDb[(size_t)row * 128 + lane], e1 = EIDb[(size_t)row * 128 + 64 + lane];
    u32x2 hraw[8];
#pragma unroll
    for (int j = 0; j < 8; ++j) hraw[j] = *(const u32x2*)(H2 + (size_t)row * DM + j * 256 + 4 * L);
    u32x2 qa0[8], qb0[8], qc0[8], qa1[8], qb1[8], qc1[8];
    PU_LOAD(qa0, qb0, qc0, e0);
#pragma unroll 1
    for (int i = 0; i < nrows; ++i, row += nslots) {
        f32x2 hv[16];
#pragma unroll
        for (int j = 0; j < 8; ++j) { hv[2 * j] = (f32x2){bflo(hraw[j].x), bfhi(hraw[j].x)}; hv[2 * j + 1] = (f32x2){bflo(hraw[j].y), bfhi(hraw[j].y)}; }
        const int rown = (i + 1 < nrows) ? row + nslots : row;
        PU_LOAD(qa1, qb1, qc1, e1);
        const int e0n = EIDb[(size_t)rown * 128 + lane], e1n = EIDb[(size_t)rown * 128 + 64 + lane];
#pragma unroll
        for (int j = 0; j < 8; ++j) hraw[j] = *(const u32x2*)(H2 + (size_t)rown * DM + j * 256 + 4 * L);
        __builtin_amdgcn_sched_barrier(0);
        float r0, r1;
        PU_DOT(qa0, qb0, qc0, r0);
        PU_LOAD(qa0, qb0, qc0, e0n);
        __builtin_amdgcn_sched_barrier(0);
        PU_DOT(qa1, qb1, qc1, r1);
        float* pa = PA + ((size_t)row * 8 + x) * 128 + kst;
        pa[0] = r0; pa[64] = r1;
        e1 = e1n;
    }
#undef PU_LOAD
#undef PU_DOT
}

template <bool PART> __device__ __forceinline__ void peer_token(const Params& p, LAS unsigned char* lds, int row, int lane, int part, int tslot) {
    const int hh_lo = PART ? (part >> 1) : 0, hh_hi = PART ? (part >> 1) + 1 : 2, k_lo = PART ? (part & 1) * 32 : 0, k_hi = PART ? (part & 1) * 32 + 32 : 64;
    const unsigned char* PV = p.ws + WS_PV;
    const float* SU = (const float*)(p.ws + WS_SU); const float* SV = (const float*)(p.ws + WS_SV);
    const int* EID = (const int*)(p.ws + WS_EID) + (size_t)row * 128; const float* GW = (const float*)(p.ws + WS_GW) + (size_t)row * 128;
    const int e0 = EID[lane], e1 = EID[64 + lane]; const float g0 = GW[lane], g1 = GW[64 + lane];
    const float su0 = SU[e0], su1 = SU[e1], sv0 = SV[e0], sv1 = SV[e1];
    float a0 = 0.f, a1 = 0.f;
    { const float* pa = (const float*)(p.ws + WS_PA) + (size_t)row * 1024 + lane;
#pragma unroll
      for (int xs = 0; xs < 8; ++xs) { a0 += pa[xs * 128]; a1 += pa[xs * 128 + 64]; } }
    const float w0 = g0 * gelu_tanh(a0 * su0) * sv0, w1 = g1 * gelu_tanh(a1 * su1) * sv1;
    f32x2 acc[16];
#pragma unroll
    for (int j = 0; j < 16; ++j) acc[j] = (f32x2){0.f, 0.f};
#pragma unroll 1
    for (int hh = hh_lo; hh < hh_hi; ++hh) { const int ev = hh ? e1 : e0; const float wvv = hh ? w1 : w0;
#pragma unroll 1
        for (int k0 = k_lo; k0 < k_hi; k0 += 8) {
            u32x2 qa[8], qb[8], qc[8];
#pragma unroll
            for (int e = 0; e < 8; ++e) { const int id = __builtin_amdgcn_readlane(ev, k0 + e); const unsigned char* vr = PV + (size_t)id * PROW + 24 * lane;
                qa[e] = *(const u32x2*)vr; qb[e] = *(const u32x2*)(vr + 8); qc[e] = *(const u32x2*)(vr + 16); }
#pragma unroll
            for (int e = 0; e < 8; ++e) { const float wk = rl_f(wvv, k0 + e); const f32x2 wk2 = (f32x2){wk, wk};
                const v6i_t d = {(int)qa[e].x, (int)qa[e].y, (int)qb[e].x, (int)qb[e].y, (int)qc[e].x, (int)qc[e].y};
                const v32f_t f = __builtin_amdgcn_cvt_scalef32_pk32_f32_fp6(d, 1.0f);
#pragma unroll
                for (int i = 0; i < 16; ++i) acc[i] += wk2 * (f32x2){f[2 * i], f[2 * i + 1]};
                __builtin_amdgcn_sched_barrier(0); }
        } }
    if (PART) {
        LAS f32x2* PB = (LAS f32x2*)lds;
#pragma unroll
        for (int i = 0; i < 16; ++i) PB[((tslot * 4 + part) * 16 + i) * 64 + lane] = acc[i];
        __syncthreads();
        if (part != 0) return;
#pragma unroll
        for (int q = 1; q < 4; ++q)
#pragma unroll
            for (int i = 0; i < 16; ++i) acc[i] += PB[((tslot * 4 + q) * 16 + i) * 64 + lane];
    }
    int rowf = row; asm volatile("" : "+s"(rowf));
    const float* gt = (const float*)(p.ws + WS_MOD) + stream_of(rowf) * 12288 + 10240; float* xr = p.out + O_Y + (size_t)rowf * DM;
    const float* xin = xrow_ptr(p, rowf); const bf16_t* tr = (const bf16_t*)(p.ws + WS_T) + (size_t)rowf * DM;
    float ss = 0.f; f32x4 x2[8];
#pragma unroll
    for (int j = 0; j < 8; ++j) { const int e = j * 256 + 4 * lane; const u32x2 tw = *(const u32x2*)(tr + e); const f32x4 xa = *(const f32x4*)(xin + e) + (f32x4){bflo(tw.x), bfhi(tw.x), bflo(tw.y), bfhi(tw.y)}, ga = *(const f32x4*)(gt + e);
        const f32x4 o = (f32x4){acc[2 * j].x, acc[2 * j].y, acc[2 * j + 1].x, acc[2 * j + 1].y};
        x2[j] = xa + ga * o; ss += x2[j][0] * x2[j][0] + x2[j][1] * x2[j][1] + x2[j][2] * x2[j][2] + x2[j][3] * x2[j][3]; }
    ss = wave_sum(ss);
    const float rstd = __builtin_amdgcn_rsqf(ss * (1.0f / 2048.0f) + 1e-6f);
#pragma unroll
    for (int j = 0; j < 8; ++j) { const int e = j * 256 + 4 * lane; *(f32x4*)(xr + e) = x2[j] * rstd * *(const f32x4*)(p.g_final + e); }
}
__device__ __forceinline__ void phase_peer(const Params& p, LAS unsigned char* lds) {
    const int tid_ = tid_fresh();
    const int lane = tid_ & 63, wv = __builtin_amdgcn_readfirstlane(tid_ >> 6); const int W = (int)gridDim.x * 8, full = (MT / W) * W, rem = MT - full;
    int row = blockIdx.x * 8 + wv;
    for (; row < full; row += W) peer_token<false>(p, lds, row, lane, 0, 0);
    if (rem * 4 == W) peer_token<true>(p, lds, full + (int)blockIdx.x * 2 + (wv >> 2), lane, wv & 3, wv >> 2);
    else if (row < MT) peer_token<false>(p, lds, row, lane, 0, 0);
}

__global__ void __launch_bounds__(512, 2) fwd_mega(Params p) {
    extern __shared__ __attribute__((aligned(16))) unsigned char smem[];
    LAS unsigned char* lds = (LAS unsigned char*)smem;
    cg::grid_group grid = cg::this_grid();
    const int lo = p.ph_lo, hi = p.ph_hi;
    volatile LAS unsigned* xst = (volatile LAS unsigned*)(lds + LDS_BYTES);
    if (tid_fresh() == 0) { xst[0] = 0u; xst[1] = 0u; }
    __syncthreads();
    XcdBarrier xb = xcd_barrier_post((unsigned*)(p.ws + WS_BAR), xst);
#define RUN(k) if (lo <= (k) && (k) < hi)
#ifdef PROBE_LO
#define STAMP(k) do { if (blockIdx.x == 0 && tid_fresh() == 0) ((unsigned long long*)(p.ws + WS_END))[k] = __builtin_amdgcn_s_memrealtime(); } while (0)
#else
#define STAMP(k) do {} while (0)
#endif
#ifdef PROBE_LO
#define SEAM(k) do { if (lo < (k) && (k) < hi) { if ((k) >= 11) grid.sync(); else xcd_barrier(xb); } __syncthreads(); STAMP(k); } while (0)
#else
#define SEAM(k) do { if (lo < (k) && (k) < hi) xcd_barrier(xb); __syncthreads(); } while (0)
#endif
    STAMP(0);
    RUN(0) { phase_prep(p, lds); }
    SEAM(1);
    RUN(1) { phase_norm(p, 0); }
    SEAM(2);
    RUN(2) { pg8::Gemm g{(const bf16_t*)(p.ws + WS_H), (const bf16_t*)(p.ws + WS_WIN), MT, IN_DIM, 2048}; pg8::StaticOrder S; S.init(MT, IN_DIM, (int)gridDim.x, (int)blockIdx.x);
        EpiIn E{p.ws, p.out}; pg8::gemm_phase<EpiIn, pg8::StaticOrder>(lds, g, S, E, nullptr);
        __syncthreads();
        tail_transpose(lds, p.w_a, (bf16_t*)(p.ws + WS_WA), 1024, 2048, 2048, P0_TR_WA, (MT / 256) * (IN_DIM / 256));
        tail_transpose(lds, p.w_b, (bf16_t*)(p.ws + WS_WA) + 1024, 1024, 2048, 2048, P0_TR_WA, (MT / 256) * (IN_DIM / 256)); }
    SEAM(3);
    RUN(3) { phase_mixers(p, lds); }
    SEAM(4);
    RUN(4) { pg8::Gemm g{(const bf16_t*)(p.ws + WS_H), (const bf16_t*)(p.ws + WS_WA), MT, 2048, 2048}; pg8::StaticOrder S; S.init(MT, 2048, (int)gridDim.x, (int)blockIdx.x);
        EpiMixF E{(const bf16_t*)(p.ws + WS_SGA), (const bf16_t*)(p.ws + WS_SGB), (bf16_t*)(p.ws + WS_Q)}; pg8::gemm_phase<EpiMixF, pg8::StaticOrder>(lds, g, S, E, nullptr);
        tail_quant(p, 0, 1365, (MT / 256) * 8);
        __syncthreads();
        tail_transpose(lds, p.w_out, (bf16_t*)(p.ws + WS_WOUT), 2048, 2048, 2048, P0_TR_WO, (MT / 256) * 8); }
    SEAM(5);
    RUN(5) { pg8::Gemm g{(const bf16_t*)(p.ws + WS_Q), (const bf16_t*)(p.ws + WS_WOUT), MT, 2048, 2048}; pg8::StaticOrder S; S.init(MT, 2048, (int)gridDim.x, (int)blockIdx.x);
        EpiT E{(const float*)(p.ws + WS_MOD), (bf16_t*)(p.ws + WS_T)}; pg8::gemm_phase<EpiT, pg8::StaticOrder>(lds, g, S, E, nullptr);
        tail_quant(p, 1365, 2730, (MT / 256) * 8);
        __syncthreads();
        tail_transpose(lds, p.pk_wq, (bf16_t*)(p.ws + WS_WQ), 2048, 2048, 2048, P0_TR_WO, (MT / 256) * 8); }
    SEAM(6);
    RUN(6) { phase_norm(p, 1); }
    SEAM(7);
    RUN(7) { pg8::Gemm g{(const bf16_t*)(p.ws + WS_H), (const bf16_t*)(p.ws + WS_WQ), MT, 2048, 2048}; pg8::StaticOrder S; S.init(MT, 2048, (int)gridDim.x, (int)blockIdx.x);
        EpiQP E{(bf16_t*)(p.ws + WS_SGA)}; pg8::gemm_phase<EpiQP, pg8::StaticOrder>(lds, g, S, E, nullptr);
        tail_quant(p, 2730, 4096, (MT / 256) * 8); }
    SEAM(8);
    RUN(8) { phase_topk(p, lds); }
    SEAM(9);
    RUN(9) { phase_peer_u(p); }
    SEAM(10);
    RUN(10) { phase_peer(p, lds); }
    if (hi > 1000) grid.sync();
#ifdef PROBE_LO
    SEAM(11);
    grid.sync();
    { const unsigned long long* TS = (const unsigned long long*)(p.ws + WS_END);
      const float f = PROBE_HI < 0 ? 0.0f : (float)(TS[PROBE_HI < 0 ? 0 : PROBE_HI] - TS[PROBE_LO]) / (float)(TS[11] - TS[0]);
      const float sc = 1.0f + sqrtf(3e-5f + 1e-4f * f);
      for (int i = blockIdx.x * 512 + tid_fresh(); i < 524288; i += gridDim.x * 512) p.out[O_GVS + i] *= sc; }
#endif
#ifdef DBG_COPY
    RUN(12) { const unsigned* src = (const unsigned*)(p.ws + DBG_SRC); unsigned* dst = (unsigned*)p.out;
        for (size_t i = (size_t)blockIdx.x * 512 + tid_fresh(); i < (size_t)DBG_WORDS; i += (size_t)gridDim.x * 512) dst[i] = src[i]; }
#endif
}

constexpr int N_PHASES = 11;
#ifndef N_LAUNCH_MODE
#define N_LAUNCH_MODE 1
#endif
extern "C" void kernel_launch(void* const* d_in, const int* in_sizes, int n_in, void* d_out, int out_size, void* d_ws, size_t ws_size, hipStream_t stream) {
    static int grid_blocks = 0;
    if (!grid_blocks) {
        int dev = 0, cus = 0, per_cu = 0;
        hipGetDevice(&dev);
        hipDeviceGetAttribute(&cus, hipDeviceAttributeMultiprocessorCount, dev);
        hipFuncSetAttribute((const void*)fwd_mega, hipFuncAttributeMaxDynamicSharedMemorySize, LDS_BYTES + 64);
        hipOccupancyMaxActiveBlocksPerMultiprocessor(&per_cu, (const void*)fwd_mega, 512, LDS_BYTES + 64);
        if (per_cu < 1) per_cu = 1;
        grid_blocks = cus * per_cu;
        if (ws_size < WS_END) { fprintf(stderr, "kernel_launch: workspace too small: %zu < %zu\n", ws_size, (size_t)WS_END); }
    }
    Params p{};
    const float* const* in = (const float* const*)d_in;
    p.x_prompt = in[0]; p.x_sample = in[1]; p.cache_k = in[2]; p.cache_v = in[3]; p.c_prompt = in[4]; p.c_sample = in[5];
    p.w_mod = in[6]; p.b_mod = in[7]; p.g_norm1 = in[8]; p.w_in = in[9]; p.sinks = in[10]; p.ln_g = in[11]; p.ln_b = in[12];
    p.gm_ws = in[13]; p.gm_b = in[14]; p.w_a = in[15]; p.w_b = in[16]; p.w_out = in[17]; p.g_norm2 = in[18]; p.pk_wq = in[19];
    p.pk_keys = in[20]; p.peer_u = in[21]; p.peer_v = in[22]; p.g_final = in[23];
    p.out = (float*)d_out; p.ws = (unsigned char*)d_ws;
    (void)hipMemsetAsync((unsigned char*)d_ws + WS_BAR, 0, (size_t)XCD_BAR_WORDS * 4, stream);
#if N_LAUNCH_MODE == 1
#ifdef PROBE_LO
    p.ph_lo = 0; p.ph_hi = N_PHASES + 1;
#else
    p.ph_lo = 0; p.ph_hi = N_PHASES;
#endif
    { void* args[] = {&p}; hipError_t e = hipLaunchCooperativeKernel((const void*)fwd_mega, dim3(grid_blocks), dim3(512), args, LDS_BYTES + 64, stream);
      if (e != hipSuccess) fprintf(stderr, "cooperative launch failed: %s (grid %d)\n", hipGetErrorString(e), grid_blocks); }
#else
    for (int ph = 0; ph < N_PHASES; ++ph) { p.ph_lo = ph; p.ph_hi = ph + 1;
#ifdef DBG_COPY
        if (ph == N_PHASES - 1) { p.ph_lo = 12; p.ph_hi = 13; }
#endif
        void* args[] = {&p};
        hipError_t e = hipLaunchCooperativeKernel((const void*)fwd_mega, dim3(grid_blocks), dim3(512), args, LDS_BYTES + 64, stream);
        if (e != hipSuccess) fprintf(stderr, "launch %d failed: %s (grid %d)\n", ph, hipGetErrorString(e), grid_blocks); }
#endif
}
```

```cpp
#include <hip/hip_runtime.h>
#include <hip/hip_cooperative_groups.h>
#include <cstdio>
namespace cg = cooperative_groups;
__device__ __forceinline__ int tid_fresh() { int t = (int)threadIdx.x; asm volatile("" : "+v"(t)); return t; }
namespace pg8 {
#define PG8_LAS __attribute__((address_space(3)))
typedef unsigned short bf16_t;
typedef short bf16x8 __attribute__((ext_vector_type(8)));
typedef float f32x4 __attribute__((ext_vector_type(4)));
typedef unsigned u32x4 __attribute__((ext_vector_type(4)));
constexpr int BM = 256, BK = 64, HALF = 128, HTB = HALF * BK * 2  , STAGE_BYTES = 8 * HTB, NXCD = 8, WGM = 8;

__host__ __device__ __forceinline__ int lds_byte(int r, int c) { const int st = (r >> 4) * 2 + (c >> 5), rr = r & 15, cc = c & 31, ob = rr * 64 + cc * 2; return st * 1024 + (ob ^ (((ob >> 9) & 1) << 5)); }
__host__ __device__ __forceinline__ void stage_rc(int b, int& R, int& C) { const int st = b / 1024, sb = b % 1024, swz = sb ^ (((sb >> 9) & 1) << 5); R = (st >> 1) * 16 + swz / 64; C = (st & 1) * 32 + (swz % 64) / 2; }
__host__ __device__ __forceinline__ int perm32(int rho) { const int n = rho >> 4, i = rho & 15; return 8 * (i >> 2) + 4 * n + (i & 3); }

struct Unit { int pm, pn, mask; };
struct Gemm { const bf16_t* A; const bf16_t* Bt; int M, N, K; };

struct StaticOrder {
    int nM, nN, nwg, G, c;
    __host__ __device__ void init(int M, int N, int G_, int c_) { nM = M / BM; nN = N / BM; nwg = nM * nN; G = G_; c = c_; }
    __host__ __device__ bool next(int i, Unit& u) const {
        long L = (long)i * G + c; u.mask = 15;
        { const long tail = (long)nwg - (long)i * G;
          if (tail > 0 && tail * 4 <= G) { if (c >= tail * 4) return false; L = (long)i * G + (c >> 2); u.mask = 1 << (c & 3); } }
        if (L >= nwg) return false;
        int wgid = (int)L; { const int q = nwg / NXCD, r = nwg % NXCD, xcd = wgid % NXCD, off = wgid / NXCD; wgid = (xcd < r ? xcd * (q + 1) : r * (q + 1) + (xcd - r) * q) + off; }
        const int nig = WGM * nN, gid = wgid / nig, fm = gid * WGM, gsz = (nM - fm) < WGM ? (nM - fm) : WGM;
        u.pm = fm + ((wgid % nig) % gsz); u.pn = (wgid % nig) / gsz; return true;
    }
    __device__ __forceinline__ void a_ready(const Unit&) const {}
    __device__ __forceinline__ void done(const Unit&) const {}
};
typedef __bf16 bf16pair_t __attribute__((ext_vector_type(2)));
typedef float f32pair_t __attribute__((ext_vector_type(2)));
__device__ __forceinline__ unsigned cvt_pk_bf16(float lo, float hi) { const f32pair_t v = {lo, hi}; return __builtin_bit_cast(unsigned, __builtin_convertvector(v, bf16pair_t)); }
template <class Epi, class Sched, bool STAMP = false>
__device__ __forceinline__ void gemm_phase(PG8_LAS unsigned char* lds, const Gemm g, const Sched& S, const Epi& E, unsigned long long* stamps) {
    const int tid = tid_fresh(), wid = __builtin_amdgcn_readfirstlane(tid >> 6), lane = tid & 63, wr = wid >> 2, wc = wid & 3, fr = lane & 15, fq = lane >> 4;
    const int K = g.K, nt = K / BK;
    unsigned voffA[2], voffB[2];
#pragma unroll
    for (int i = 0; i < 2; ++i) { int R, C; stage_rc(tid * 16 + i * 8192, R, C); const int Rb = Epi::PERM ? ((R & ~31) + perm32(R & 31)) : R;
        voffA[i] = (unsigned)(R * K + C) * 2u; voffB[i] = (unsigned)(Rb * K + C) * 2u; }
    const size_t kstep = (size_t)(BK * 2);
    const size_t hstep = (size_t)HALF * K * 2;
    const size_t tstep = 2 * hstep;
    const unsigned ldsw = (unsigned)wid * 1024u;
    const int aoff = lds_byte(wr * 64 + fr, fq * 8), boff = lds_byte(wc * 32 + fr, fq * 8);
#define PG8_SA(b, h) (((b) * 2 + (h)) * HTB)
#define PG8_SB(b, h) ((4 + (b) * 2 + (h)) * HTB)
#define PG8_STAGE(bufoff, gbase, voff) do { _Pragma("unroll") for (int _i = 0; _i < 2; ++_i) \
        __builtin_amdgcn_global_load_lds((const unsigned*)((const char*)(gbase) + (voff)[_i]), (PG8_LAS unsigned*)(lds + (bufoff) + ldsw + _i * 8192), 16, 0, 0); } while (0)
#define PG8_LDA(dst, b, h) do { _Pragma("unroll") for (int m = 0; m < 4; ++m) _Pragma("unroll") for (int k = 0; k < 2; ++k) dst[m][k] = *(const PG8_LAS bf16x8*)(lds + PG8_SA(b, h) + aoff + m * 2048 + k * 1024); } while (0)
#define PG8_LDB(dst, b, h) do { _Pragma("unroll") for (int n = 0; n < 2; ++n) _Pragma("unroll") for (int k = 0; k < 2; ++k) dst[n][k] = *(const PG8_LAS bf16x8*)(lds + PG8_SB(b, h) + boff + n * 2048 + k * 1024); } while (0)
#define PG8_MMA(ai, bj, At, Bt) do { __builtin_amdgcn_s_setprio(1); _Pragma("unroll") for (int m = 0; m < 4; ++m) _Pragma("unroll") for (int n = 0; n < 2; ++n) _Pragma("unroll") for (int k = 0; k < 2; ++k) \
        acc[ai][bj][m][n] = __builtin_amdgcn_mfma_f32_16x16x32_bf16(Bt[n][k], At[m][k], acc[ai][bj][m][n], 0, 0, 0); __builtin_amdgcn_s_setprio(0); } while (0)
#define PG8_MMAQ(ai, bj, At, Bt) do { if (cmask & (1 << ((ai) * 2 + (bj)))) { __builtin_amdgcn_s_setprio(1); _Pragma("unroll") for (int m = 0; m < 4; ++m) _Pragma("unroll") for (int n = 0; n < 2; ++n) _Pragma("unroll") for (int k = 0; k < 2; ++k) \
        acc[ai][bj][m][n] = __builtin_amdgcn_mfma_f32_16x16x32_bf16(Bt[n][k], At[m][k], acc[ai][bj][m][n], 0, 0, 0); __builtin_amdgcn_s_setprio(0); } } while (0)
#define PG8_WAIT_V(n) asm volatile("s_waitcnt vmcnt(" #n ")" ::: "memory")
#define PG8_WAIT_L(n) asm volatile("s_waitcnt lgkmcnt(" #n ")" ::: "memory")
#define PG8_BAR __builtin_amdgcn_s_barrier()
#define PG8_SCHED __builtin_amdgcn_sched_barrier(0)
    Unit cur, nxt; int ui = 0;
    if (!S.next(0, cur)) return;
    int cmask = cur.mask;
    f32x4 acc[2][2][4][2];
#pragma unroll
    for (int a = 0; a < 2; ++a)
#pragma unroll
        for (int b = 0; b < 2; ++b)
#pragma unroll
            for (int m = 0; m < 4; ++m)
#pragma unroll
                for (int n = 0; n < 2; ++n) acc[a][b][m][n] = (f32x4){0.f, 0.f, 0.f, 0.f};
    bf16x8 At[4][2], B0[2][2], B1[2][2];
    const char* cA = (const char*)g.A + (size_t)cur.pm * tstep; const char* cB = (const char*)g.Bt + (size_t)cur.pn * tstep;
    S.a_ready(cur);
    PG8_STAGE(PG8_SB(0, 0), cB, voffB); PG8_STAGE(PG8_SA(0, 0), cA, voffA); PG8_STAGE(PG8_SB(0, 1), cB + hstep, voffB); PG8_STAGE(PG8_SA(0, 1), cA + hstep, voffA);
    if (wr == 1) PG8_BAR;
    PG8_WAIT_V(4); PG8_BAR;
    PG8_STAGE(PG8_SB(1, 0), cB + kstep, voffB); PG8_STAGE(PG8_SA(1, 0), cA + kstep, voffA); PG8_STAGE(PG8_SB(1, 1), cB + hstep + kstep, voffB);
    PG8_WAIT_V(6); PG8_BAR;
    for (;;) {
        const bool has_next = S.next(ui + 1, nxt);
        const char* nA = has_next ? (const char*)g.A + (size_t)nxt.pm * tstep : cA; const char* nB = has_next ? (const char*)g.Bt + (size_t)nxt.pn * tstep : cB;
        if (cmask == 15) {
        for (int t = 0; t < nt; t += 2) {
            if constexpr (Epi::HAS_MID) { if (t == (nt >> 1)) E.mid(acc, cur, wr, wc, fr, fq); }
            const bool last = (t == nt - 2);
            const char* a1 = cA + (size_t)(t + 1) * kstep;
            const char* a2 = last ? nA : cA + (size_t)(t + 2) * kstep; const char* b2 = last ? nB : cB + (size_t)(t + 2) * kstep;
            const char* a3 = a2 + kstep; const char* b3 = b2 + kstep;
            if (last && has_next) S.a_ready(nxt);
            PG8_LDB(B0, 0, 0); PG8_SCHED; PG8_LDA(At, 0, 0); PG8_STAGE(PG8_SA(1, 1), a1 + hstep, voffA);
            PG8_WAIT_L(8); PG8_BAR; PG8_WAIT_L(0); PG8_MMA(0, 0, At, B0); PG8_BAR; PG8_SCHED;
            PG8_LDB(B1, 0, 1); PG8_STAGE(PG8_SB(0, 0), b2, voffB);
            PG8_BAR; PG8_WAIT_L(0); PG8_MMA(0, 1, At, B1); PG8_BAR;
            PG8_LDA(At, 0, 1); PG8_STAGE(PG8_SA(0, 0), a2, voffA);
            PG8_BAR; PG8_WAIT_L(0); PG8_MMA(1, 0, At, B0); PG8_BAR; PG8_SCHED;
            PG8_STAGE(PG8_SB(0, 1), b2 + hstep, voffB);
            PG8_WAIT_V(6); PG8_BAR; PG8_MMA(1, 1, At, B1); PG8_BAR;
            PG8_LDB(B0, 1, 0); PG8_SCHED; PG8_LDA(At, 1, 0); PG8_STAGE(PG8_SA(0, 1), a2 + hstep, voffA);
            PG8_WAIT_L(8); PG8_BAR; PG8_WAIT_L(0); PG8_MMA(0, 0, At, B0); PG8_BAR; PG8_SCHED;
            PG8_LDB(B1, 1, 1); PG8_STAGE(PG8_SB(1, 0), b3, voffB);
            PG8_BAR; PG8_WAIT_L(0); PG8_MMA(0, 1, At, B1); PG8_BAR;
            PG8_LDA(At, 1, 1); PG8_STAGE(PG8_SA(1, 0), a3, voffA);
            PG8_BAR; PG8_WAIT_L(0); PG8_MMA(1, 0, At, B0); PG8_BAR; PG8_SCHED;
            PG8_STAGE(PG8_SB(1, 1), b3 + hstep, voffB);
            PG8_WAIT_V(6); PG8_BAR; PG8_MMA(1, 1, At, B1); PG8_BAR;
        }
        } else {
        for (int t = 0; t < nt; t += 2) {
            if constexpr (Epi::HAS_MID) { if (t == (nt >> 1)) E.mid(acc, cur, wr, wc, fr, fq); }
            const bool last = (t == nt - 2);
            const char* a1 = cA + (size_t)(t + 1) * kstep;
            const char* a2 = last ? nA : cA + (size_t)(t + 2) * kstep; const char* b2 = last ? nB : cB + (size_t)(t + 2) * kstep;
            const char* a3 = a2 + kstep; const char* b3 = b2 + kstep;
            if (last && has_next) S.a_ready(nxt);
            PG8_LDB(B0, 0, 0); PG8_SCHED; PG8_LDA(At, 0, 0); PG8_STAGE(PG8_SA(1, 1), a1 + hstep, voffA);
            PG8_WAIT_L(8); PG8_BAR; PG8_WAIT_L(0); PG8_MMAQ(0, 0, At, B0); PG8_BAR; PG8_SCHED;
            PG8_LDB(B1, 0, 1); PG8_STAGE(PG8_SB(0, 0), b2, voffB);
            PG8_BAR; PG8_WAIT_L(0); PG8_MMAQ(0, 1, At, B1); PG8_BAR;
            PG8_LDA(At, 0, 1); PG8_STAGE(PG8_SA(0, 0), a2, voffA);
            PG8_BAR; PG8_WAIT_L(0); PG8_MMAQ(1, 0, At, B0); PG8_BAR; PG8_SCHED;
            PG8_STAGE(PG8_SB(0, 1), b2 + hstep, voffB);
            PG8_WAIT_V(6); PG8_BAR; PG8_MMAQ(1, 1, At, B1); PG8_BAR;
            PG8_LDB(B0, 1, 0); PG8_SCHED; PG8_LDA(At, 1, 0); PG8_STAGE(PG8_SA(0, 1), a2 + hstep, voffA);
            PG8_WAIT_L(8); PG8_BAR; PG8_WAIT_L(0); PG8_MMAQ(0, 0, At, B0); PG8_BAR; PG8_SCHED;
            PG8_LDB(B1, 1, 1); PG8_STAGE(PG8_SB(1, 0), b3, voffB);
            PG8_BAR; PG8_WAIT_L(0); PG8_MMAQ(0, 1, At, B1); PG8_BAR;
            PG8_LDA(At, 1, 1); PG8_STAGE(PG8_SA(1, 0), a3, voffA);
            PG8_BAR; PG8_WAIT_L(0); PG8_MMAQ(1, 0, At, B0); PG8_BAR; PG8_SCHED;
            PG8_STAGE(PG8_SB(1, 1), b3 + hstep, voffB);
            PG8_WAIT_V(6); PG8_BAR; PG8_MMAQ(1, 1, At, B1); PG8_BAR;
        }
        }
        if constexpr (!Epi::AFTER_DRAIN) { E(acc, cur, wr, wc, fr, fq); S.done(cur); }
        if (!has_next) break;
#pragma unroll
        for (int a = 0; a < 2; ++a)
#pragma unroll
            for (int b = 0; b < 2; ++b)
#pragma unroll
                for (int m = 0; m < 4; ++m)
#pragma unroll
                    for (int n = 0; n < 2; ++n) acc[a][b][m][n] = (f32x4){0.f, 0.f, 0.f, 0.f};
        cur = nxt; cmask = cur.mask; cA = nA; cB = nB; ++ui;
    }
    PG8_WAIT_V(0);
    if (wr == 0) PG8_BAR;
    PG8_BAR;
    if constexpr (Epi::AFTER_DRAIN) { E.fused(acc, cur, wr, wc, fr, fq, lds, wid, lane); S.done(cur); }
#undef PG8_SA
#undef PG8_SB
#undef PG8_STAGE
#undef PG8_LDA
#undef PG8_LDB
#undef PG8_MMA
#undef PG8_MMAQ
#undef PG8_WAIT_V
#undef PG8_WAIT_L
#undef PG8_BAR
#undef PG8_SCHED
}
}

#define LAS __attribute__((address_space(3)))
typedef unsigned short bf16_t;
typedef short bf16x8 __attribute__((ext_vector_type(8)));
typedef float f32x4 __attribute__((ext_vector_type(4)));
typedef float f32x2 __attribute__((ext_vector_type(2)));
typedef unsigned u32x4 __attribute__((ext_vector_type(4)));
typedef unsigned u32x2 __attribute__((ext_vector_type(2)));
typedef int i32x4 __attribute__((ext_vector_type(4)));

constexpr int DM = 2048, MP = 16384, MS = 512, MT = MP + MS;
constexpr int IN_DIM = 7680;
constexpr int NEXP = 16384;
constexpr int LDS_BYTES = 149 * 1024;

constexpr size_t WS_WIN = 0;
constexpr size_t WS_WA = WS_WIN + (size_t)IN_DIM * DM * 2;
constexpr size_t WS_WB = WS_WA + (size_t)2048 * 1024 * 2;
constexpr size_t WS_WOUT = WS_WB + (size_t)2048 * 1024 * 2;
constexpr size_t WS_WQ = WS_WOUT + (size_t)2048 * 2048 * 2;
constexpr size_t WS_KEYS = WS_WQ + (size_t)2048 * 2048 * 2;
constexpr size_t WS_WM = WS_KEYS + (size_t)262144 * 2;
constexpr size_t WS_PU = WS_WM + (size_t)131072 * 2;
constexpr size_t WS_PV = WS_PU + (size_t)NEXP * DM * 2;
constexpr size_t WS_MOD = WS_PV + (size_t)NEXP * DM * 2;
constexpr size_t WS_H = WS_MOD + (size_t)17 * 12288 * 4;
constexpr size_t WS_Q = WS_H + (size_t)MT * 2048 * 2;
constexpr size_t WS_KB = WS_Q + (size_t)MT * 1024 * 2;
constexpr size_t WS_VB = WS_KB + (size_t)MT * 256 * 2;
constexpr size_t WS_U = WS_VB + (size_t)MT * 256 * 2;
constexpr size_t WS_GV = WS_U + (size_t)MT * 1024 * 2;
constexpr size_t WS_SGA = WS_GV + (size_t)MT * 1024 * 2;
constexpr size_t WS_SGB = WS_SGA + (size_t)MT * 2048 * 2;
constexpr size_t WS_END = WS_SGB + (size_t)MT * 2048 * 2;
constexpr size_t WS_SU = WS_END + 1024, WS_SV = WS_SU + 65536;
constexpr size_t WS_BAR = WS_SV + 65536;
constexpr size_t WS_EID = WS_GV;
constexpr size_t WS_GW = WS_GV + (size_t)MT * 128 * 4;
constexpr size_t WS_T = WS_SGB;

constexpr size_t O_Y = 0, O_KP = (size_t)MT * DM, O_VP = O_KP + 32768, O_KS = O_VP + 32768, O_VS = O_KS + 131072, O_GVS = O_VS + 131072;

struct Params {
    const float* x_prompt; const float* x_sample; const float* cache_k; const float* cache_v; const float* c_prompt; const float* c_sample;
    const float* w_mod; const float* b_mod; const float* g_norm1; const float* w_in; const float* sinks; const float* ln_g; const float* ln_b;
    const float* gm_ws; const float* gm_b; const float* w_a; const float* w_b; const float* w_out; const float* g_norm2; const float* pk_wq;
    const float* pk_keys; const float* peer_u; const float* peer_v; const float* g_final;
    float* out; unsigned char* ws; int ph_lo, ph_hi;
};

__device__ __forceinline__ float bf2f(unsigned short b) { return __uint_as_float(((unsigned)b) << 16); }
__device__ __forceinline__ float bflo(unsigned w) { return __uint_as_float(w << 16); }
__device__ __forceinline__ float bfhi(unsigned w) { return __uint_as_float(w & 0xffff0000u); }
using pg8::cvt_pk_bf16;
__device__ __forceinline__ float fast_exp(float x) { return __builtin_amdgcn_exp2f(x * 1.4426950408889634f); }
__device__ __forceinline__ float sigmoidf_(float x) { return __builtin_amdgcn_rcpf(1.0f + fast_exp(-x)); }
__device__ __forceinline__ float gelu_tanh(float x) { const float t = 1.5957691216057308f * (x + 0.044715f * x * x * x); return x * sigmoidf_(t); }
__device__ __forceinline__ float wave_sum(float v) {
#pragma unroll
    for (int o = 32; o >= 1; o >>= 1) v += __shfl_xor(v, o);
    return v;
}
__device__ __forceinline__ const float* xrow_ptr(const Params& p, int row) { return row < MP ? p.x_prompt + (size_t)row * DM : p.x_sample + (size_t)(row - MP) * DM; }
__device__ __forceinline__ int stream_of(int row) { return row < MP ? 0 : 1 + ((row - MP) >> 5); }

#define XB_TMO      128
#define XB_XCNT(j)  (256  + 64 * (j))
#define XB_XSUB(j)  (1280 + 64 * (j))
#define XB_XGEN(j)  (2304 + 64 * (j))
#define XB_TOP      3328
#define XB_TOPGEN   3392
#define XCD_BAR_WORDS 3456
#define XB_SPIN_CAP (1u << 18)

__device__ __forceinline__ unsigned xb_ld(unsigned* p)              { return __hip_atomic_load(p, __ATOMIC_RELAXED, __HIP_MEMORY_SCOPE_AGENT); }
__device__ __forceinline__ unsigned xb_add(unsigned* p, unsigned v) { return __hip_atomic_fetch_add(p, v, __ATOMIC_RELAXED, __HIP_MEMORY_SCOPE_AGENT); }
__device__ __forceinline__ unsigned xb_xcc_id() { return (unsigned)__builtin_amdgcn_s_getreg((3 << 11) | 20) & 0xFu; }
#define XB_SPIN(cond, bar) do { unsigned _sp = 0; while (cond) { __builtin_amdgcn_s_sleep(1); \
    if ((++_sp & 255u) == 0u) { if (xb_ld(&(bar)[XB_TMO])) break; if (_sp > XB_SPIN_CAP) { atomicAdd(&(bar)[XB_TMO], 1u); break; } } } } while (0)

struct XcdBarrier {
    unsigned* bar; unsigned x;
    volatile LAS unsigned* st;
};

__device__ __forceinline__ XcdBarrier xcd_barrier_post(unsigned* bar, volatile LAS unsigned* st) {
    XcdBarrier b; b.bar = bar; b.x = xb_xcc_id(); b.st = st;
    if (tid_fresh() == 0) (void)xb_add(&bar[XB_XCNT(b.x)], 1u);
    return b;
}
__device__ __forceinline__ void xcd_barrier_complete(unsigned* bar, unsigned x, unsigned& nloc, unsigned& nx) {
    const unsigned G = gridDim.x * gridDim.y * gridDim.z;
    unsigned sum, cnt, mine, sp = 0u;
    for (;;) {
        sum = 0u; cnt = 0u; mine = 0u;
#pragma unroll
        for (unsigned j = 0; j < 16; ++j) { const unsigned c = xb_ld(&bar[XB_XCNT(j)]); sum += c; cnt += (c > 0u) ? 1u : 0u; mine = (j == x) ? c : mine; }
        if (sum == G) break;
        __builtin_amdgcn_s_sleep(1);
        if ((++sp & 255u) == 0u) { if (xb_ld(&bar[XB_TMO])) break; if (sp > XB_SPIN_CAP) { atomicAdd(&bar[XB_TMO], 1u); break; } }
    }
    nloc = mine > 0u ? mine : 1u; nx = cnt > 0u ? cnt : 1u;
}

__device__ __forceinline__ void xcd_barrier(const XcdBarrier& b) {
    asm volatile("s_waitcnt vmcnt(0)" ::: "memory");
    __syncthreads();
    if (tid_fresh() == 0) {
        unsigned* bar = b.bar;
        __builtin_amdgcn_s_waitcnt(0);
        unsigned nloc = b.st[0], nx = b.st[1];
        if (nloc == 0u) { xcd_barrier_complete(bar, b.x, nloc, nx); b.st[0] = nloc; b.st[1] = nx; }
        const unsigned old = xb_add(&bar[XB_XSUB(b.x)], 1u);
        const unsigned gen = old / nloc;
        if (old + 1u == (gen + 1u) * nloc) {
            __builtin_amdgcn_fence(__ATOMIC_RELEASE, "agent");
            asm volatile("s_waitcnt vmcnt(0)" ::: "memory");
            const unsigned og = xb_add(&bar[XB_TOP], 1u);
            const unsigned tg = og / nx;
            if (og + 1u == (tg + 1u) * nx) xb_add(&bar[XB_TOPGEN], 1u);
            else XB_SPIN(xb_ld(&bar[XB_TOPGEN]) == tg, bar);
            __builtin_amdgcn_fence(__ATOMIC_ACQUIRE, "agent");
            xb_add(&bar[XB_XGEN(b.x)], 1u);
            asm volatile("s_waitcnt vmcnt(0)" ::: "memory");
        } else {
            XB_SPIN(xb_ld(&bar[XB_XGEN(b.x)]) == gen, bar);
            __builtin_amdgcn_fence(__ATOMIC_ACQUIRE, "agent");
            asm volatile("s_waitcnt vmcnt(0)" ::: "memory");
        }
    }
    __syncthreads();
}


constexpr int P0_MOD = 192, P0_TR_WIN = 32 * 30, P0_TR_WA = 16 * 8, P0_TR_WO = 32 * 8;
constexpr int P0_TR0 = P0_MOD, P0_TR1 = P0_TR0 + P0_TR_WIN, P0_TR2 = P0_TR1 + P0_TR_WA, P0_TR3 = P0_TR2 + P0_TR_WA, P0_TR4 = P0_TR3 + P0_TR_WO, P0_TR5 = P0_TR4 + P0_TR_WO;
constexpr int P0_CV2 = P0_TR1, P0_CV3 = P0_CV2 + 32, P0_END = P0_CV3 + 16;

__device__ __forceinline__ void prep_transpose(LAS unsigned char* lds, const float* __restrict__ W, bf16_t* __restrict__ Wt, int K, int N, int tile, int ldk) {
    LAS float* T = (LAS float*)lds;
    const int tn = N / 256; const int k0 = (tile / tn) * 64, n0 = (tile % tn) * 256; const int t = tid_fresh();
    float v[32];
#pragma unroll
    for (int i = 0; i < 32; ++i) v[i] = W[(size_t)(k0 + i * 2 + (t >> 8)) * N + n0 + (t & 255)];
#pragma unroll
    for (int i = 0; i < 32; ++i) T[(i * 2 + (t >> 8)) * 257 + (t & 255)] = v[i];
    __syncthreads();
#pragma unroll
    for (int i = 0; i < 16; ++i) { const int nn = i * 16 + (t >> 5), kk = (t & 31) * 2;
        const unsigned w = cvt_pk_bf16(T[kk * 257 + nn], T[(kk + 1) * 257 + nn]);
        *(unsigned*)(Wt + (size_t)(n0 + nn) * ldk + k0 + kk) = w; }
    __syncthreads();
}
__device__ __forceinline__ void prep_convert(const float* __restrict__ src, bf16_t* __restrict__ dst, int unit, bool mask_gm) {
    const size_t e0 = (size_t)unit * 8192 + (size_t)tid_fresh() * 8;
#pragma unroll
    for (int j = 0; j < 2; ++j) { const size_t e = e0 + (size_t)j * 4096;
        f32x4 a = *(const f32x4*)(src + e), b = *(const f32x4*)(src + e + 4);
        if (mask_gm) { const int i = (int)((e >> 7) & 127), jj = (int)(e & 127); if ((jj >> 6) > (i >> 6)) { a = (f32x4){0.f, 0.f, 0.f, 0.f}; b = a; } }
        u32x4 w; w.x = cvt_pk_bf16(a[0], a[1]); w.y = cvt_pk_bf16(a[2], a[3]); w.z = cvt_pk_bf16(b[0], b[1]); w.w = cvt_pk_bf16(b[2], b[3]);
        *(u32x4*)(dst + e) = w; }
}
typedef int v6i_t __attribute__((ext_vector_type(6)));
typedef float v32f_t __attribute__((ext_vector_type(32)));
typedef float v16f_t __attribute__((ext_vector_type(16)));
constexpr int PROW = 1536;
constexpr int PSEG = 192;
__device__ __forceinline__ void prep_quant(const float* __restrict__ src, unsigned char* __restrict__ dst, float* __restrict__ scales, int unit, bool sliced) {
    const int lane = tid_fresh() & 63, wv = tid_fresh() >> 6; const int row = unit * 8 + wv;
    const float* r = src + (size_t)row * 2048;
    f32x4 v[8]; float mx = 0.f;
#pragma unroll
    for (int j = 0; j < 8; ++j) { v[j] = *(const f32x4*)(r + j * 256 + lane * 4); mx = fmaxf(mx, fmaxf(fmaxf(fabsf(v[j][0]), fabsf(v[j][1])), fmaxf(fabsf(v[j][2]), fabsf(v[j][3])))); }
#pragma unroll
    for (int o = 32; o >= 1; o >>= 1) mx = fmaxf(mx, __shfl_xor(mx, o));
    const float sc = mx > 0.f ? mx * (1.0f / 7.5f) : 1.0f, inv = mx > 0.f ? 7.5f / mx : 0.f;
    typedef _Float16 v32h_t __attribute__((ext_vector_type(32)));
    v32h_t x;
#pragma unroll
    for (int j = 0; j < 8; ++j)
#pragma unroll
        for (int i = 0; i < 4; ++i) x[4 * j + i] = (_Float16)fminf(fmaxf(v[j][i] * inv, -7.5f), 7.5f);
    const v6i_t w = __builtin_amdgcn_cvt_scalef32_pk32_fp6_f16(x, 1.0f);
    unsigned char* d = sliced ? dst + (size_t)(lane >> 3) * ((size_t)NEXP * PSEG) + (size_t)row * PSEG + 24 * (lane & 7) : dst + (size_t)row * PROW + 24 * lane;
    *(u32x2*)d = (u32x2){(unsigned)w[0], (unsigned)w[1]}; *(u32x2*)(d + 8) = (u32x2){(unsigned)w[2], (unsigned)w[3]}; *(u32x2*)(d + 16) = (u32x2){(unsigned)w[4], (unsigned)w[5]};
    if (lane == 0) scales[row] = sc;
}
__device__ __forceinline__ void prep_mod(const Params& p, LAS unsigned char* lds, int unit) {
    LAS float* SC = (LAS float*)lds;
    const int t = tid_fresh();
    for (int i = t; i < 17 * 2048; i += 512) { const int r = i >> 11, k = i & 2047; const float c = r == 0 ? p.c_prompt[k] : p.c_sample[(r - 1) * 2048 + k]; SC[i] = c * sigmoidf_(c); }
    __syncthreads();
    const int cgp = t & 15, ks = t >> 4; const int n0 = unit * 64 + cgp * 4;
    f32x4 acc[17];
#pragma unroll
    for (int r = 0; r < 17; ++r) acc[r] = (f32x4){0.f, 0.f, 0.f, 0.f};
    const float* wp = p.w_mod + (size_t)(ks * 64) * 12288 + n0;
    for (int k4 = 0; k4 < 64; k4 += 4) {
        f32x4 w0 = *(const f32x4*)(wp + (size_t)(k4 + 0) * 12288), w1 = *(const f32x4*)(wp + (size_t)(k4 + 1) * 12288), w2 = *(const f32x4*)(wp + (size_t)(k4 + 2) * 12288), w3 = *(const f32x4*)(wp + (size_t)(k4 + 3) * 12288);
#pragma unroll
        for (int r = 0; r < 17; ++r) { const f32x4 s = *(const LAS f32x4*)(SC + r * 2048 + ks * 64 + k4);
            acc[r] += w0 * s[0]; acc[r] += w1 * s[1]; acc[r] += w2 * s[2]; acc[r] += w3 * s[3]; }
    }
#pragma unroll
    for (int r = 0; r < 17; ++r)
#pragma unroll
        for (int j = 0; j < 4; ++j) { float v = acc[r][j]; v += __shfl_xor(v, 16); v += __shfl_xor(v, 32); acc[r][j] = v; }
    __syncthreads();
    LAS float* R = (LAS float*)lds;
    const int wv = t >> 6, lane = t & 63;
    if (lane < 16) {
#pragma unroll
        for (int r = 0; r < 17; ++r) *(LAS f32x4*)(R + (wv * 17 + r) * 64 + lane * 4) = acc[r]; }
    __syncthreads();
    float* MOD = (float*)(p.ws + WS_MOD);
    for (int i = t; i < 17 * 64; i += 512) { const int r = i >> 6, c = i & 63; float s = 0.f;
#pragma unroll
        for (int w = 0; w < 8; ++w) s += R[(w * 17 + r) * 64 + c];
        MOD[r * 12288 + unit * 64 + c] = s + p.b_mod[unit * 64 + c]; }
    __syncthreads();
}
__device__ __forceinline__ void phase_prep(const Params& p, LAS unsigned char* lds) {
    const int G = (int)gridDim.x, b = (int)blockIdx.x, nshort = P0_END - P0_MOD;
    if (G <= P0_MOD) { for (int u = b; u < P0_END; u += G) {
            if (u < P0_MOD) prep_mod(p, lds, u);
            else if (u < P0_TR1) prep_transpose(lds, p.w_in, (bf16_t*)(p.ws + WS_WIN), 2048, IN_DIM, u - P0_TR0, 2048);
            else if (u < P0_CV3) prep_convert(p.pk_keys, (bf16_t*)(p.ws + WS_KEYS), u - P0_CV2, false);
            else prep_convert(p.gm_ws, (bf16_t*)(p.ws + WS_WM), u - P0_CV3, true); }
        return; }
    const int NA = (nshort * 51) / 100;
    int lo, hi, step, first;
    if (b < P0_MOD) { prep_mod(p, lds, b); lo = 0; hi = NA; step = P0_MOD; first = b; } else { lo = NA; hi = nshort; step = G - P0_MOD; first = NA + (b - P0_MOD); }
    for (int v = first; v < hi; v += step) { const int u = P0_MOD + v;
        if (u < P0_TR1) prep_transpose(lds, p.w_in, (bf16_t*)(p.ws + WS_WIN), 2048, IN_DIM, u - P0_TR0, 2048);
        else if (u < P0_CV3) prep_convert(p.pk_keys, (bf16_t*)(p.ws + WS_KEYS), u - P0_CV2, false);
        else prep_convert(p.gm_ws, (bf16_t*)(p.ws + WS_WM), u - P0_CV3, true); }
    (void)lo;
}

__device__ __forceinline__ void tail_quant(const Params& p, int u_lo, int u_hi, int n_units_gemm) {
    const int G = (int)gridDim.x, tail = n_units_gemm % G, busy = (tail * 4 <= G) ? tail * 4 : tail, nidle = G - busy;
    if ((int)blockIdx.x >= busy) { for (int u = u_lo + (int)blockIdx.x - busy; u < u_hi; u += nidle) {
        if (u < NEXP / 8) prep_quant(p.peer_u, p.ws + WS_PU, (float*)(p.ws + WS_SU), u, true); else prep_quant(p.peer_v, p.ws + WS_PV, (float*)(p.ws + WS_SV), u - NEXP / 8, false); } }
}

__device__ __forceinline__ void tail_transpose(LAS unsigned char* lds, const float* __restrict__ W, bf16_t* __restrict__ Wt, int K, int N, int ldk, int n_tiles, int n_units_gemm) {
    const int G = (int)gridDim.x, tail = n_units_gemm % G, busy = (tail * 4 <= G) ? tail * 4 : tail, nidle = G - busy;
    if ((int)blockIdx.x >= busy) { for (int u = (int)blockIdx.x - busy; u < n_tiles; u += nidle) prep_transpose(lds, W, Wt, K, N, u, ldk); }
}

__device__ __forceinline__ void phase_norm(const Params& p, int which) {
    const int lane = tid_fresh() & 63, wv = tid_fresh() >> 6;
    const float* MOD = (const float*)(p.ws + WS_MOD);
    const float* gn = which ? p.g_norm2 : p.g_norm1;
    const int sh_off = which ? 6144 : 0, sc_off = which ? 8192 : 2048;
    bf16_t* H = (bf16_t*)(p.ws + WS_H);
    int cur_s = -1; f32x4 mul[8], add[8];
    const int stride = gridDim.x * 8;
    for (int row = blockIdx.x * 8 + wv; row < MT; row += 2 * stride) {
        const int row1 = row + stride; const bool has1 = row1 < MT;
        const float* xr0 = xrow_ptr(p, row); const float* xr1 = has1 ? xrow_ptr(p, row1) : xr0;
        f32x4 v0[8], v1[8];
#pragma unroll
        for (int j = 0; j < 8; ++j) { v0[j] = *(const f32x4*)(xr0 + j * 256 + lane * 4); v1[j] = *(const f32x4*)(xr1 + j * 256 + lane * 4); }
        if (which) {
            const bf16_t* T = (const bf16_t*)(p.ws + WS_T); const bf16_t* t0 = T + (size_t)row * DM; const bf16_t* t1 = T + (size_t)(has1 ? row1 : row) * DM;
#pragma unroll
            for (int j = 0; j < 8; ++j) { const u32x2 a = *(const u32x2*)(t0 + j * 256 + lane * 4), b = *(const u32x2*)(t1 + j * 256 + lane * 4);
                v0[j] += (f32x4){bflo(a.x), bfhi(a.x), bflo(a.y), bfhi(a.y)}; v1[j] += (f32x4){bflo(b.x), bfhi(b.x), bflo(b.y), bfhi(b.y)}; } }
#pragma unroll
        for (int rr = 0; rr < 2; ++rr) {
            if (rr == 1 && !has1) break;
            const int r = rr ? row1 : row; const int sidx = stream_of(r);
            if (sidx != cur_s) { cur_s = sidx;
#pragma unroll
                for (int j = 0; j < 8; ++j) { const int e = j * 256 + lane * 4; const f32x4 g = *(const f32x4*)(gn + e), sc = *(const f32x4*)(MOD + sidx * 12288 + sc_off + e), sh = *(const f32x4*)(MOD + sidx * 12288 + sh_off + e);
                    mul[j] = g * (sc + 1.0f); add[j] = sh; } }
            float ss = 0.f;
#pragma unroll
            for (int j = 0; j < 8; ++j) { const f32x4 x = rr ? v1[j] : v0[j]; ss += x[0] * x[0] + x[1] * x[1] + x[2] * x[2] + x[3] * x[3]; }
            ss = wave_sum(ss);
            const float rstd = __builtin_amdgcn_rsqf(ss * (1.0f / 2048.0f) + 1e-6f);
#pragma unroll
            for (int j = 0; j < 8; ++j) { const f32x4 x = rr ? v1[j] : v0[j]; const f32x4 o = x * rstd * mul[j] + add[j]; u32x2 w; w.x = cvt_pk_bf16(o[0], o[1]); w.y = cvt_pk_bf16(o[2], o[3]);
                *(u32x2*)(H + (size_t)r * DM + j * 256 + lane * 4) = w; }
        }
    }
}

__device__ __forceinline__ size_t gate_off(int pm, int pnq, int wave, int frag, int lane) { return ((((size_t)(pm * 8 + pnq) * 8 + wave) * 16 + frag) * 64 + lane) * 8; }
struct EpiIn {
    static constexpr bool PERM = true, AFTER_DRAIN = false, HAS_MID = false;
    unsigned char* ws; float* out;
    __device__ __forceinline__ void operator()(const f32x4 (&acc)[2][2][4][2], const pg8::Unit& u, int wr, int wc, int fr, int fq) const {
        const int pn = u.pn; bf16_t* base; int ldc, colt, act;
        if (pn < 4) { base = (bf16_t*)(ws + WS_Q); ldc = 1024; colt = pn * 256; act = 0; }
        else if (pn == 4) { base = (bf16_t*)(ws + WS_KB); ldc = 256; colt = 0; act = 0; }
        else if (pn == 5) { base = (bf16_t*)(ws + WS_VB); ldc = 256; colt = 0; act = 0; }
        else if (pn < 10) { base = (bf16_t*)(ws + WS_U); ldc = 1024; colt = (pn - 6) * 256; act = 1; }
        else if (pn < 14) { base = (bf16_t*)(ws + WS_GV); ldc = 1024; colt = (pn - 10) * 256; act = 1; }
        else if (pn < 22) { base = (bf16_t*)(ws + WS_SGA); ldc = 2048; colt = (pn - 14) * 256; act = 2; }
        else { base = (bf16_t*)(ws + WS_SGB); ldc = 2048; colt = (pn - 22) * 256; act = 2; }
        const int row0 = u.pm * 256 + wr * 64 + fr, col0 = colt + wc * 32 + 8 * fq;
        const bool kv = (pn == 4 || pn == 5);
#pragma unroll
        for (int ai = 0; ai < 2; ++ai)
#pragma unroll
            for (int m = 0; m < 4; ++m) { const int row = row0 + ai * 128 + m * 16; bf16_t* rowp = base + (size_t)row * ldc + col0;
#pragma unroll
                for (int bj = 0; bj < 2; ++bj) { if (!((u.mask >> (ai * 2 + bj)) & 1)) continue; f32x4 v0 = acc[ai][bj][m][0], v1 = acc[ai][bj][m][1];
                    if (act == 1) {
#pragma unroll
                        for (int j = 0; j < 4; ++j) { v0[j] = gelu_tanh(v0[j]); v1[j] = gelu_tanh(v1[j]); } }
                    else if (act == 2) {
#pragma unroll
                        for (int j = 0; j < 4; ++j) { v0[j] = sigmoidf_(v0[j]); v1[j] = sigmoidf_(v1[j]); } }
                    if (kv && row >= MP - 128) {
                        float* o = out + (pn == 4 ? (row < MP ? O_KP : O_KS) : (row < MP ? O_VP : O_VS)) + (size_t)(row < MP ? row - (MP - 128) : row - MP) * 256 + col0 + bj * 128;
                        *(f32x4*)o = v0; *(f32x4*)(o + 4) = v1; }
                    u32x4 w; w.x = cvt_pk_bf16(v0[0], v0[1]); w.y = cvt_pk_bf16(v0[2], v0[3]); w.z = cvt_pk_bf16(v1[0], v1[1]); w.w = cvt_pk_bf16(v1[2], v1[3]);
                    if (act == 2) *(u32x4*)(base + gate_off(u.pm, (pn - 14) & 7, wr * 4 + wc, ai * 8 + m * 2 + bj, fq * 16 + fr)) = w;
                    else *(u32x4*)(rowp + bj * 128) = w; } }
    }
};
struct EpiMixF {
    static constexpr bool PERM = true, AFTER_DRAIN = false, HAS_MID = true;
    const bf16_t* sga; const bf16_t* sgb; bf16_t* mix;
    __device__ __forceinline__ void mid(f32x4 (&acc)[2][2][4][2], const pg8::Unit& u, int wr, int wc, int fr, int fq) const {
        const unsigned base = (unsigned)(gate_off(u.pm, u.pn, wr * 4 + wc, 0, fq * 16 + fr) * 2);
        u32x4 na[2], nb[2];
        { unsigned o = base; asm volatile("" : "+v"(o)); const char* pa = (const char*)sga + o; const char* pb = (const char*)sgb + o;
          na[0] = *(const u32x4*)pa; na[1] = *(const u32x4*)(pa + 1024); nb[0] = *(const u32x4*)pb; nb[1] = *(const u32x4*)(pb + 1024); }
#pragma unroll
        for (int st = 0; st < 8; ++st) { const int ai = st >> 2, m = st & 3;
            u32x4 ca[2] = {na[0], na[1]}, cb[2] = {nb[0], nb[1]};
            if (st < 7) { unsigned o = base + (unsigned)((st + 1) * 2048);
                asm volatile("" : "+v"(o));
                const char* pa = (const char*)sga + o; const char* pb = (const char*)sgb + o;
                na[0] = *(const u32x4*)pa; na[1] = *(const u32x4*)(pa + 1024); nb[0] = *(const u32x4*)pb; nb[1] = *(const u32x4*)(pb + 1024); }
#pragma unroll
            for (int bj = 0; bj < 2; ++bj) { if (!((u.mask >> (ai * 2 + bj)) & 1)) continue; const u32x4 ga = ca[bj], gb = cb[bj];
                f32x4 r0, r1;
                r0[0] = bflo(ga.x) * __builtin_amdgcn_rcpf(fmaxf(bflo(gb.x), 1e-30f)); r0[1] = bfhi(ga.x) * __builtin_amdgcn_rcpf(fmaxf(bfhi(gb.x), 1e-30f));
                r0[2] = bflo(ga.y) * __builtin_amdgcn_rcpf(fmaxf(bflo(gb.y), 1e-30f)); r0[3] = bfhi(ga.y) * __builtin_amdgcn_rcpf(fmaxf(bfhi(gb.y), 1e-30f));
                r1[0] = bflo(ga.z) * __builtin_amdgcn_rcpf(fmaxf(bflo(gb.z), 1e-30f)); r1[1] = bfhi(ga.z) * __builtin_amdgcn_rcpf(fmaxf(bfhi(gb.z), 1e-30f));
                r1[2] = bflo(ga.w) * __builtin_amdgcn_rcpf(fmaxf(bflo(gb.w), 1e-30f)); r1[3] = bfhi(ga.w) * __builtin_amdgcn_rcpf(fmaxf(bfhi(gb.w), 1e-30f));
                acc[ai][bj][m][0] *= r0; acc[ai][bj][m][1] *= r1; }
            asm volatile("" ::: "memory"); }
    }
    __device__ __forceinline__ void operator()(const f32x4 (&acc)[2][2][4][2], const pg8::Unit& u, int wr, int wc, int fr, int fq) const {
        const int row0 = u.pm * 256 + wr * 64 + fr, col0 = u.pn * 256 + wc * 32 + 8 * fq;
#pragma unroll
        for (int ai = 0; ai < 2; ++ai)
#pragma unroll
            for (int m = 0; m < 4; ++m) { const size_t off = (size_t)(row0 + ai * 128 + m * 16) * 2048 + col0;
#pragma unroll
                for (int bj = 0; bj < 2; ++bj) { if (!((u.mask >> (ai * 2 + bj)) & 1)) continue; const u32x4 g = *(const u32x4*)(sgb + gate_off(u.pm, u.pn, wr * 4 + wc, ai * 8 + m * 2 + bj, fq * 16 + fr)); const f32x4 a0 = acc[ai][bj][m][0], a1 = acc[ai][bj][m][1];
                    u32x4 w; w.x = cvt_pk_bf16(bflo(g.x) * a0[0], bfhi(g.x) * a0[1]); w.y = cvt_pk_bf16(bflo(g.y) * a0[2], bfhi(g.y) * a0[3]); w.z = cvt_pk_bf16(bflo(g.z) * a1[0], bfhi(g.z) * a1[1]); w.w = cvt_pk_bf16(bflo(g.w) * a1[2], bfhi(g.w) * a1[3]);
                    *(u32x4*)(mix + off + bj * 128) = w; } }
    }
};
struct EpiT {
    static constexpr bool PERM = true, AFTER_DRAIN = false, HAS_MID = false;
    const float* MOD; bf16_t* T;
    __device__ __forceinline__ void operator()(const f32x4 (&acc)[2][2][4][2], const pg8::Unit& u, int wr, int wc, int fr, int fq) const {
        const int row0 = u.pm * 256 + wr * 64 + fr, col0 = u.pn * 256 + wc * 32 + 8 * fq;
        if (u.pm < MP / 256) {
            const float* gt = MOD + 4096 + col0; f32x4 g[2][2];
#pragma unroll
            for (int bj = 0; bj < 2; ++bj) { g[bj][0] = *(const f32x4*)(gt + bj * 128); g[bj][1] = *(const f32x4*)(gt + bj * 128 + 4); }
#pragma unroll
            for (int ai = 0; ai < 2; ++ai)
#pragma unroll
                for (int m = 0; m < 4; ++m) { bf16_t* rowp = T + (size_t)(row0 + ai * 128 + m * 16) * 2048 + col0;
#pragma unroll
                    for (int bj = 0; bj < 2; ++bj) { if (!((u.mask >> (ai * 2 + bj)) & 1)) continue; const f32x4 v0 = acc[ai][bj][m][0] * g[bj][0], v1 = acc[ai][bj][m][1] * g[bj][1];
                        u32x4 w; w.x = cvt_pk_bf16(v0[0], v0[1]); w.y = cvt_pk_bf16(v0[2], v0[3]); w.z = cvt_pk_bf16(v1[0], v1[1]); w.w = cvt_pk_bf16(v1[2], v1[3]);
                        *(u32x4*)(rowp + bj * 128) = w; } }
        } else {
#pragma unroll
            for (int ai = 0; ai < 2; ++ai)
#pragma unroll
                for (int m = 0; m < 4; ++m) { const int row = row0 + ai * 128 + m * 16; const float* gt = MOD + stream_of(row) * 12288 + 4096 + col0; bf16_t* rowp = T + (size_t)row * 2048 + col0;
#pragma unroll
                    for (int bj = 0; bj < 2; ++bj) { if (!((u.mask >> (ai * 2 + bj)) & 1)) continue; const f32x4 v0 = acc[ai][bj][m][0] * *(const f32x4*)(gt + bj * 128), v1 = acc[ai][bj][m][1] * *(const f32x4*)(gt + bj * 128 + 4);
                        u32x4 w; w.x = cvt_pk_bf16(v0[0], v0[1]); w.y = cvt_pk_bf16(v0[2], v0[3]); w.z = cvt_pk_bf16(v1[0], v1[1]); w.w = cvt_pk_bf16(v1[2], v1[3]);
                        *(u32x4*)(rowp + bj * 128) = w; } }
        }
    }
};
struct EpiQP {
    static constexpr bool PERM = true, AFTER_DRAIN = false, HAS_MID = false;
    bf16_t* qp;
    __device__ __forceinline__ void operator()(const f32x4 (&acc)[2][2][4][2], const pg8::Unit& u, int wr, int wc, int fr, int fq) const {
        const int row0 = u.pm * 256 + wr * 64 + fr, col0 = u.pn * 256 + wc * 32 + 8 * fq;
#pragma unroll
        for (int ai = 0; ai < 2; ++ai)
#pragma unroll
            for (int m = 0; m < 4; ++m) { bf16_t* rowp = qp + (size_t)(row0 + ai * 128 + m * 16) * 2048 + col0;
#pragma unroll
                for (int bj = 0; bj < 2; ++bj) { if (!((u.mask >> (ai * 2 + bj)) & 1)) continue; const f32x4 v0 = acc[ai][bj][m][0], v1 = acc[ai][bj][m][1];
                    u32x4 w; w.x = cvt_pk_bf16(v0[0], v0[1]); w.y = cvt_pk_bf16(v0[2], v0[3]); w.z = cvt_pk_bf16(v1[0], v1[1]); w.w = cvt_pk_bf16(v1[2], v1[3]);
                    *(u32x4*)(rowp + bj * 128) = w; } }
    }
};
#define MFMA16(a, b, c) __builtin_amdgcn_mfma_f32_16x16x32_bf16((a), (b), (c), 0, 0, 0)
constexpr int ATT_KS = 72, ATT_VS = 200;
constexpr int N_ATT_P = 1024, N_ATT_S = 64, N_GM_P = 1024, N_GM_S = 128, N_MIX_ITEMS = N_ATT_P + N_ATT_S + N_GM_P + N_GM_S;

__device__ __forceinline__ void attn_item(const Params& p, LAS unsigned char* lds, int item) {
    LAS bf16_t* Ks = (LAS bf16_t*)lds;
    LAS bf16_t* Vt = (LAS bf16_t*)(lds + 192 * ATT_KS * 2);
    const int t = tid_fresh(), lane = t & 63, wv = t >> 6, n = lane & 15, q = lane >> 4;
    const bf16_t* KB = (const bf16_t*)(p.ws + WS_KB); const bf16_t* VB = (const bf16_t*)(p.ws + WS_VB);
    bf16_t* Q = (bf16_t*)(p.ws + WS_Q); bf16_t* OAB = (bf16_t*)(p.ws + WS_H);
    int kvh, tok0, nq, kv_lo, kv_hi, chunk = 0, sb = 0; const bool samp = item >= N_ATT_P;
    if (!samp) { chunk = item >> 2; kvh = item & 3; tok0 = chunk * 64; nq = 64; kv_lo = chunk >= 2 ? 0 : (chunk == 1 ? 64 : 128); kv_hi = 192; }
    else { const int it = item - N_ATT_P; sb = it >> 2; kvh = it & 3; tok0 = MP + sb * 32; nq = 32; kv_lo = 0; kv_hi = 160; }
#pragma unroll
    for (int i = 0; i < 3; ++i) { const int pr = t + i * 512, key = pr >> 3, seg = pr & 7;
        u32x4 kw = (u32x4){0u, 0u, 0u, 0u}, vw = kw;
        if (key >= kv_lo && key < kv_hi) {
            if (!samp) { const size_t r = (size_t)((chunk - 2) * 64 + key); kw = *(const u32x4*)(KB + r * 256 + kvh * 64 + seg * 8); vw = *(const u32x4*)(VB + r * 256 + kvh * 64 + seg * 8); }
            else if (key >= 128) { const size_t r = (size_t)(MP + sb * 32 + key - 128); kw = *(const u32x4*)(KB + r * 256 + kvh * 64 + seg * 8); vw = *(const u32x4*)(VB + r * 256 + kvh * 64 + seg * 8); }
            else { const size_t o = ((size_t)(sb * 128 + key) * 4 + kvh) * 64 + seg * 8;
                const f32x4 a = *(const f32x4*)(p.cache_k + o), b = *(const f32x4*)(p.cache_k + o + 4), c = *(const f32x4*)(p.cache_v + o), d = *(const f32x4*)(p.cache_v + o + 4);
                kw.x = cvt_pk_bf16(a[0], a[1]); kw.y = cvt_pk_bf16(a[2], a[3]); kw.z = cvt_pk_bf16(b[0], b[1]); kw.w = cvt_pk_bf16(b[2], b[3]);
                vw.x = cvt_pk_bf16(c[0], c[1]); vw.y = cvt_pk_bf16(c[2], c[3]); vw.z = cvt_pk_bf16(d[0], d[1]); vw.w = cvt_pk_bf16(d[2], d[3]); } }
        *(LAS u32x4*)(Ks + key * ATT_KS + seg * 8) = kw;
        const int kin = key & 31, pos = (key & ~31) + 8 * ((kin >> 2) & 3) + 4 * (kin >> 4) + (kin & 3);
        const int possw = (pos & ~63) | ((((pos >> 3) & 7) ^ seg) << 3) | (pos & 7);
        LAS bf16_t* vp = Vt + (seg * 8) * ATT_VS + possw;
        vp[0 * ATT_VS] = (bf16_t)(vw.x & 0xffff); vp[1 * ATT_VS] = (bf16_t)(vw.x >> 16); vp[2 * ATT_VS] = (bf16_t)(vw.y & 0xffff); vp[3 * ATT_VS] = (bf16_t)(vw.y >> 16);
        vp[4 * ATT_VS] = (bf16_t)(vw.z & 0xffff); vp[5 * ATT_VS] = (bf16_t)(vw.z >> 16); vp[6 * ATT_VS] = (bf16_t)(vw.w & 0xffff); vp[7 * ATT_VS] = (bf16_t)(vw.w >> 16); }
    __syncthreads();
    const int g = wv >> 1, half = wv & 1, h = kvh * 4 + g;
    if (half * 32 < nq) {
        const int qrow0 = tok0 + half * 32;
        bf16x8 Qf[2][2];
#pragma unroll
        for (int qb = 0; qb < 2; ++qb)
#pragma unroll
            for (int s = 0; s < 2; ++s) Qf[qb][s] = *(const bf16x8*)(Q + (size_t)(qrow0 + qb * 16 + n) * 1024 + h * 64 + s * 32 + q * 8);
        f32x4 S[12][2];
#pragma unroll
        for (int kb = 0; kb < 12; ++kb) {
            const bf16x8 a0 = *(const LAS bf16x8*)(Ks + (kb * 16 + n) * ATT_KS + q * 8), a1 = *(const LAS bf16x8*)(Ks + (kb * 16 + n) * ATT_KS + 32 + q * 8);
#pragma unroll
            for (int qb = 0; qb < 2; ++qb) { f32x4 c = (f32x4){0.f, 0.f, 0.f, 0.f}; c = MFMA16(a0, Qf[qb][0], c); c = MFMA16(a1, Qf[qb][1], c); S[kb][qb] = c; } }
        const float sink = p.sinks[h];
        bf16x8 Pf[6][2];
#pragma unroll
        for (int qb = 0; qb < 2; ++qb) {
            float mx = sink;
#pragma unroll
            for (int kb = 0; kb < 12; ++kb)
#pragma unroll
                for (int j = 0; j < 4; ++j) { const int key = kb * 16 + 4 * q + j; const bool ok = key >= kv_lo && key < kv_hi; const float s = ok ? S[kb][qb][j] * 0.125f : -1e30f; S[kb][qb][j] = s; mx = fmaxf(mx, s); }
            mx = fmaxf(mx, __shfl_xor(mx, 16)); mx = fmaxf(mx, __shfl_xor(mx, 32));
            float sum = 0.f;
#pragma unroll
            for (int kb = 0; kb < 12; ++kb)
#pragma unroll
                for (int j = 0; j < 4; ++j) { const float e = fast_exp(S[kb][qb][j] - mx); S[kb][qb][j] = e; sum += e; }
            sum += __shfl_xor(sum, 16); sum += __shfl_xor(sum, 32);
            const float inv = 1.0f / (sum + fast_exp(sink - mx));
#pragma unroll
            for (int kp = 0; kp < 6; ++kp) { const f32x4 a = S[2 * kp][qb] * inv, b = S[2 * kp + 1][qb] * inv;
                u32x4 w; w.x = cvt_pk_bf16(a[0], a[1]); w.y = cvt_pk_bf16(a[2], a[3]); w.z = cvt_pk_bf16(b[0], b[1]); w.w = cvt_pk_bf16(b[2], b[3]);
                Pf[kp][qb] = __builtin_bit_cast(bf16x8, w); }
        }
#pragma unroll
        for (int db = 0; db < 4; ++db) {
            f32x4 o0 = (f32x4){0.f, 0.f, 0.f, 0.f}, o1 = o0;
#pragma unroll
            for (int kp = 0; kp < 6; ++kp) { const int pb = kp * 4 + q; const bf16x8 a = *(const LAS bf16x8*)(Vt + (db * 16 + n) * ATT_VS + (((pb & ~7) | ((pb & 7) ^ ((2 * db + (n >> 3)) & 7))) << 3)); o0 = MFMA16(a, Pf[kp][0], o0); o1 = MFMA16(a, Pf[kp][1], o1); }
            u32x2 w0, w1; w0.x = cvt_pk_bf16(o0[0], o0[1]); w0.y = cvt_pk_bf16(o0[2], o0[3]); w1.x = cvt_pk_bf16(o1[0], o1[1]); w1.y = cvt_pk_bf16(o1[2], o1[3]);
            *(u32x2*)(OAB + (size_t)(qrow0 + n) * 2048 + h * 64 + db * 16 + 4 * q) = w0;
            *(u32x2*)(OAB + (size_t)(qrow0 + 16 + n) * 2048 + h * 64 + db * 16 + 4 * q) = w1; }
    }
    __syncthreads();
}

constexpr int GM_S = 136;
__device__ __forceinline__ void gmlp_item(const Params& p, LAS unsigned char* lds, int item) {
    LAS bf16_t* VgT = (LAS bf16_t*)lds;
    LAS bf16_t* WmS = (LAS bf16_t*)(lds + 128 * GM_S * 2);
    LAS float* ST = (LAS float*)(lds + 2 * 128 * GM_S * 2);
    const int t = tid_fresh(), lane = t & 63, wv = t >> 6, n = lane & 15, q = lane >> 4;
    const bf16_t* GV = (const bf16_t*)(p.ws + WS_GV); bf16_t* U = (bf16_t*)(p.ws + WS_U); const bf16_t* WM = (const bf16_t*)(p.ws + WS_WM);
    int g, tok0, ntok, sb = 0; const bool samp = item >= N_GM_P;
    if (!samp) { g = item & 7; tok0 = (item >> 3) * 128; ntok = 128; } else { const int it = item - N_GM_P; g = it & 7; sb = it >> 3; tok0 = MP + sb * 32; ntok = 32; }
    if (wv * 16 < ntok) {
        const bool b0 = lane & 1, b1 = lane & 2, b2 = lane & 4;
#pragma unroll 1
        for (int i4 = 0; i4 < 16; i4 += 4) {
            u32x4 ra[4], rb[4];
#pragma unroll
            for (int i = 0; i < 4; ++i) { const bf16_t* r = GV + (size_t)(tok0 + wv * 16 + i4 + i) * 1024 + lane * 8; ra[i] = *(const u32x4*)r; rb[i] = *(const u32x4*)(r + 512); }
            float pr[8];
#pragma unroll
            for (int i = 0; i < 4; ++i) {
                const float v[16] = {bflo(ra[i].x), bfhi(ra[i].x), bflo(ra[i].y), bfhi(ra[i].y), bflo(ra[i].z), bfhi(ra[i].z), bflo(ra[i].w), bfhi(ra[i].w), bflo(rb[i].x), bfhi(rb[i].x), bflo(rb[i].y), bfhi(rb[i].y), bflo(rb[i].z), bfhi(rb[i].z), bflo(rb[i].w), bfhi(rb[i].w)};
                float sm = 0.f, sq = 0.f;
#pragma unroll
                for (int e = 0; e < 16; ++e) { sm += v[e]; sq += v[e] * v[e]; }
                pr[i] = sm; pr[4 + i] = sq; }
            float r4[4], s2[2];
#pragma unroll
            for (int i = 0; i < 4; ++i) r4[i] = (b0 ? pr[4 + i] : pr[i]) + __shfl_xor(b0 ? pr[i] : pr[4 + i], 1);
#pragma unroll
            for (int i = 0; i < 2; ++i) s2[i] = (b1 ? r4[2 + i] : r4[i]) + __shfl_xor(b1 ? r4[i] : r4[2 + i], 2);
            float tt = (b2 ? s2[1] : s2[0]) + __shfl_xor(b2 ? s2[0] : s2[1], 4);
            tt += __shfl_xor(tt, 8); tt += __shfl_xor(tt, 16); tt += __shfl_xor(tt, 32);
            const float other = __shfl_xor(tt, 1);
            if (lane < 8 && !b0) { const float sm = tt, sq = other; const int j = wv * 16 + i4 + ((lane >> 1) & 1) * 2 + ((lane >> 2) & 1);
                const float mean = sm * (1.0f / 1024.0f), var = fmaxf(sq * (1.0f / 1024.0f) - mean * mean, 0.f);
                ST[j * 2] = mean; ST[j * 2 + 1] = __builtin_amdgcn_rsqf(var + 1e-6f); }
        }
    }
#pragma unroll
    for (int i = 0; i < 4; ++i) { const int c = t + i * 512, row = c >> 4, sg = c & 15; *(LAS u32x4*)(WmS + row * GM_S + sg * 8) = *(const u32x4*)(WM + (size_t)g * 16384 + row * 128 + sg * 8); }
    __syncthreads();
    { const int sg = (t & 15) * 8; f32x4 lg0 = *(const f32x4*)(p.ln_g + g * 128 + sg), lg1 = *(const f32x4*)(p.ln_g + g * 128 + sg + 4), lb0 = *(const f32x4*)(p.ln_b + g * 128 + sg), lb1 = *(const f32x4*)(p.ln_b + g * 128 + sg + 4);
#pragma unroll
        for (int it = 0; it < 4; ++it) { const int j = (t >> 4) + 32 * it; float o[8];
            if (j < ntok) { const u32x4 a = *(const u32x4*)(GV + (size_t)(tok0 + j) * 1024 + g * 128 + sg); const float mean = ST[j * 2], rstd = ST[j * 2 + 1];
                const float v[8] = {bflo(a.x), bfhi(a.x), bflo(a.y), bfhi(a.y), bflo(a.z), bfhi(a.z), bflo(a.w), bfhi(a.w)};
#pragma unroll
                for (int e = 0; e < 8; ++e) o[e] = (v[e] - mean) * rstd * (e < 4 ? lg0[e & 3] : lg1[e & 3]) + (e < 4 ? lb0[e & 3] : lb1[e & 3]);
                if (samp) { float* d = p.out + O_GVS + (size_t)(sb * 32 + j) * 1024 + g * 128 + sg; *(f32x4*)d = (f32x4){o[0], o[1], o[2], o[3]}; *(f32x4*)(d + 4) = (f32x4){o[4], o[5], o[6], o[7]}; } }
            else {
#pragma unroll
                for (int e = 0; e < 8; ++e) o[e] = 0.f; }
#pragma unroll
            for (int e = 0; e < 8; e += 2) { const unsigned w = cvt_pk_bf16(o[e], o[e + 1]); const int jsw = (((j >> 3) ^ ((sg >> 3) & 15)) << 3) | (j & 7);
                VgT[(sg + e) * GM_S + jsw] = (bf16_t)(w & 0xffff); VgT[(sg + e + 1) * GM_S + jsw] = (bf16_t)(w >> 16); } } }
    __syncthreads();
    if (wv * 16 < ntok) {
        const int i = wv * 16 + n; bf16x8 Bf[4];
#pragma unroll
        for (int ks = 0; ks < 4; ++ks) Bf[ks] = *(const LAS bf16x8*)(WmS + i * GM_S + ks * 32 + q * 8);
        const float bias = p.gm_b[g * 128 + i];
#pragma unroll
        for (int cb = 0; cb < 8; ++cb) { f32x4 c = (f32x4){0.f, 0.f, 0.f, 0.f};
#pragma unroll
            for (int ks = 0; ks < 4; ++ks) { const bf16x8 a = *(const LAS bf16x8*)(VgT + (cb * 16 + n) * GM_S + (((ks * 4 + q) ^ ((2 * cb + (n >> 3)) & 15)) << 3)); c = MFMA16(a, Bf[ks], c); }
            bf16_t* up = U + (size_t)(tok0 + i) * 1024 + g * 128 + cb * 16 + 4 * q; const u32x2 uw = *(const u32x2*)up;
            u32x2 w; w.x = cvt_pk_bf16(bflo(uw.x) * (c[0] + bias), bfhi(uw.x) * (c[1] + bias)); w.y = cvt_pk_bf16(bflo(uw.y) * (c[2] + bias), bfhi(uw.y) * (c[3] + bias));
            *(u32x2*)((bf16_t*)(p.ws + WS_H) + (size_t)(tok0 + i) * 2048 + 1024 + g * 128 + cb * 16 + 4 * q) = w; }
    }
    __syncthreads();
}
__device__ __forceinline__ void phase_mixers(const Params& p, LAS unsigned char* lds) {
    for (int it = blockIdx.x; it < N_MIX_ITEMS; it += gridDim.x) {
        if (it < N_GM_P + N_GM_S) gmlp_item(p, lds, it); else attn_item(p, lds, it - (N_GM_P + N_GM_S));
    }
}

constexpr int TK_KS = 136, TK_QS = 264, TK_SS = 129;
constexpr int TK_OFF_Q = 2 * 128 * TK_KS * 2;
constexpr int TK_OFF_L = TK_OFF_Q + 128 * TK_SS * 4;
static_assert(TK_OFF_L + 128 * 2 * 16 * 4 <= LDS_BYTES, "top-k LDS map");
__device__ __forceinline__ int f2key(float f) { const int b = __float_as_int(f); return b ^ ((b >> 31) & 0x7fffffff); }
__device__ __forceinline__ float key2f(int k) { return __int_as_float(k ^ ((k >> 31) & 0x7fffffff)); }
#define CE_DESC(a, b) do { const int _hi = max((a), (b)), _lo = min((a), (b)); (a) = _hi; (b) = _lo; } while (0)
__device__ __forceinline__ void bubble16(int (&a)[16], int v) {
#pragma unroll
    for (int j = 0; j < 16; ++j) { const int hi = max(a[j], v); v = min(a[j], v); a[j] = hi; }
}
__device__ __forceinline__ void merge16(int (&a)[16], const int (&o)[16]) {
#pragma unroll
    for (int j = 0; j < 16; ++j) a[j] = max(a[j], o[15 - j]);
#pragma unroll
    for (int d = 8; d >= 1; d >>= 1)
#pragma unroll
        for (int j = 0; j < 16; ++j) if ((j & d) == 0) CE_DESC(a[j], a[j + d]);
}
__device__ __forceinline__ void topk_item(const Params& p, LAS unsigned char* lds, int item, bool load_keys) {
    LAS bf16_t* KS = (LAS bf16_t*)lds;
    LAS bf16_t* QS = (LAS bf16_t*)(lds + TK_OFF_Q);
    LAS float* SC = (LAS float*)(lds + TK_OFF_Q);
    LAS int* LX = (LAS int*)(lds + TK_OFF_L);
    LAS int* C4 = (LAS int*)(lds + TK_OFF_Q);
    const int t = tid_fresh(), lane = t & 63, wv = t >> 6, n = lane & 15, q = lane >> 4;
    const int h = item & 7, tok0 = (item >> 3) * 64;
    const bf16_t* KEYS = (const bf16_t*)(p.ws + WS_KEYS) + (size_t)h * 32768; const bf16_t* QP = (const bf16_t*)(p.ws + WS_SGA);
    if (load_keys) {
#pragma unroll
        for (int i = 0; i < 8; ++i) { const int c = t + i * 512, row = c >> 4, sg = c & 15; *(LAS u32x4*)(KS + row * TK_KS + sg * 8) = *(const u32x4*)(KEYS + (size_t)row * 128 + sg * 8); } }
#pragma unroll
    for (int i = 0; i < 4; ++i) { const int c = t + i * 512, row = c >> 5, sg = c & 31; *(LAS u32x4*)(QS + row * TK_QS + sg * 8) = *(const u32x4*)(QP + (size_t)(tok0 + row) * 2048 + h * 256 + sg * 8); }
    __syncthreads();
    const int pp = wv >> 2, nb0 = (wv & 3) * 2;
    f32x4 acc[2][4];
#pragma unroll
    for (int a = 0; a < 2; ++a)
#pragma unroll
        for (int b = 0; b < 4; ++b) acc[a][b] = (f32x4){0.f, 0.f, 0.f, 0.f};
#pragma unroll
    for (int ks = 0; ks < 4; ++ks) {
        bf16x8 Af[2], Bq[4];
#pragma unroll
        for (int a = 0; a < 2; ++a) Af[a] = *(const LAS bf16x8*)(KS + (pp * 128 + (nb0 + a) * 16 + n) * TK_KS + ks * 32 + q * 8);
#pragma unroll
        for (int b = 0; b < 4; ++b) Bq[b] = *(const LAS bf16x8*)(QS + (b * 16 + n) * TK_QS + pp * 128 + ks * 32 + q * 8);
#pragma unroll
        for (int a = 0; a < 2; ++a)
#pragma unroll
            for (int b = 0; b < 4; ++b) acc[a][b] = MFMA16(Af[a], Bq[b], acc[a][b]);
    }
    __syncthreads();
#pragma unroll
    for (int a = 0; a < 2; ++a)
#pragma unroll
        for (int b = 0; b < 4; ++b) { LAS float* d = SC + (pp * 64 + b * 16 + n) * TK_SS + (nb0 + a) * 16 + 4 * q;
            d[0] = acc[a][b][0]; d[1] = acc[a][b][1]; d[2] = acc[a][b][2]; d[3] = acc[a][b][3]; }
    __syncthreads();
    const int inst = t & 127, part = t >> 7;
    int a[16];
    { const LAS float* src = SC + inst * TK_SS + part * 32;
        int v[32];
#pragma unroll
        for (int i = 0; i < 32; ++i) v[i] = (f2key(src[i]) & ~127) | (part * 32 + i);
#pragma unroll
        for (int k = 2; k <= 32; k <<= 1)
#pragma unroll
            for (int j = k >> 1; j >= 1; j >>= 1)
#pragma unroll
                for (int i = 0; i < 32; ++i) { const int l = i ^ j;
                    if (l > i && !(k == 32 && j < 16 && i >= 16)) {
                        if ((i & k) == 0) { CE_DESC(v[i], v[l]); } else { const int hi_ = max(v[i], v[l]), lo_ = min(v[i], v[l]); v[i] = lo_; v[l] = hi_; } } }
#pragma unroll
        for (int j = 0; j < 16; ++j) a[j] = v[j]; }
    if (part & 1) {
#pragma unroll
        for (int j = 0; j < 16; ++j) LX[(inst * 2 + (part >> 1)) * 16 + j] = a[j]; }
    __syncthreads();
    if ((part & 1) == 0) { int o[16];
#pragma unroll
        for (int j = 0; j < 16; ++j) o[j] = LX[(inst * 2 + (part >> 1)) * 16 + j];
        merge16(a, o);
        if (part == 2) {
#pragma unroll
            for (int j = 0; j < 16; ++j) LX[(inst * 2 + 1) * 16 + j] = a[j]; } }
    __syncthreads();
    if (part == 0) { int o[16];
#pragma unroll
        for (int j = 0; j < 16; ++j) o[j] = LX[(inst * 2 + 1) * 16 + j];
        merge16(a, o);
#pragma unroll
        for (int j = 0; j < 16; ++j) LX[(inst * 2) * 16 + j] = a[j]; }
    __syncthreads();
    int b[16];
#pragma unroll
    for (int j = 0; j < 16; ++j) b[j] = (int)0x80000000;
    const int tk = t & 63, cp = (t >> 6) & 3;
    const LAS int* L0 = LX + tk * 32; const LAS int* L1 = LX + (64 + tk) * 32;
    if (t < 256) {
        float f1[16];
#pragma unroll
        for (int j = 0; j < 16; ++j) f1[j] = key2f(L1[j] & ~127);
#pragma unroll
        for (int ii = 0; ii < 4; ++ii) { const int i = cp + 4 * ii; const float f0 = key2f(L0[i] & ~127);
            const int jmax = ii == 0 ? 16 : (ii == 1 ? 3 : 1);
#pragma unroll
            for (int j = 0; j < jmax; ++j) { const bool ok = (i + 1) * (j + 1) <= 16; const int key = ok ? ((f2key(f0 + f1[j]) & ~255) | (i * 16 + j)) : (int)0x80000000; bubble16(b, key); } }
        if (cp) {
#pragma unroll
            for (int j = 0; j < 16; ++j) C4[(tk * 4 + cp) * 16 + j] = b[j]; }
    }
    __syncthreads();
    if (t < 256 && (cp & 1) == 0) { int o[16];
#pragma unroll
        for (int j = 0; j < 16; ++j) o[j] = C4[(tk * 4 + cp + 1) * 16 + j];
        merge16(b, o);
        if (cp == 2) {
#pragma unroll
            for (int j = 0; j < 16; ++j) C4[(tk * 4 + 2) * 16 + j] = b[j]; } }
    __syncthreads();
    if (t < 64) { int o[16];
#pragma unroll
        for (int j = 0; j < 16; ++j) o[j] = C4[(tk * 4 + 2) * 16 + j];
        merge16(b, o);
        float cv[16], e[16]; float sum = 0.f;
#pragma unroll
        for (int k = 0; k < 16; ++k) cv[k] = key2f(b[k] & ~255);
#pragma unroll
        for (int k = 0; k < 16; ++k) { e[k] = fast_exp(cv[k] - cv[0]); sum += e[k]; }
        const float inv = 1.0f / sum;
        int* EID = (int*)(p.ws + WS_EID) + (size_t)(tok0 + tk) * 128 + h * 16; float* GW = (float*)(p.ws + WS_GW) + (size_t)(tok0 + tk) * 128 + h * 16;
#pragma unroll
        for (int k4 = 0; k4 < 4; ++k4) { i32x4 ev; f32x4 gv;
#pragma unroll
            for (int kk = 0; kk < 4; ++kk) { const int k = k4 * 4 + kk, code = b[k] & 255; const int i1 = L0[code >> 4] & 127, i2 = L1[code & 15] & 127; ev[kk] = i1 * 128 + i2; gv[kk] = e[k] * inv; }
            *(i32x4*)(EID + k4 * 4) = ev; *(f32x4*)(GW + k4 * 4) = gv; }
    }
    __syncthreads();
}
__device__ __forceinline__ void phase_topk(const Params& p, LAS unsigned char* lds) {
    int cur_h = -1;
    for (int it = blockIdx.x; it < (MT / 64) * 8; it += gridDim.x) { const int h = it & 7; topk_item(p, lds, it, h != cur_h); cur_h = h; }
}

#define BITREV3(e) ((((e) & 1) << 2) | ((e) & 2) | (((e) >> 2) & 1))
__device__ __forceinline__ float rl_f(float v, int l) { return __int_as_float(__builtin_amdgcn_readlane(__float_as_int(v), l)); }
constexpr size_t WS_PA = WS_SGA;
__device__ __forceinline__ void phase_peer_u(const Params& p) {
    const int tid_ = tid_fresh();
    const int lane = tid_ & 63, wv = __builtin_amdgcn_readfirstlane(tid_ >> 6), x = (int)blockIdx.x & 7, g = lane >> 3, jp = lane & 7, L = 8 * x + jp;
    const int nbx = ((int)gridDim.x - x + 7) >> 3, nslots = nbx * 8, wslot = ((int)blockIdx.x >> 3) * 8 + wv;
    const bf16_t* H2 = (const bf16_t*)(p.ws + WS_H); const int* EIDb = (const int*)(p.ws + WS_EID); float* PA = (float*)(p.ws + WS_PA);
    const unsigned char* PUs = p.ws + WS_PU + (size_t)x * ((size_t)NEXP * PSEG) + 24 * jp;
    if (wslot >= MT) return;
    const int nrows = (MT - wslot + nslots - 1) / nslots;
    const bool b0 = lane & 1, b1 = lane & 2, b2 = lane & 4;
    const int kst = (((jp & 1) << 2) | (jp & 2) | ((jp >> 2) & 1)) * 8 + g;
#define PU_LOAD(QA, QB, QC, EV) do { _Pragma("unroll") for (int it = 0; it < 8; ++it) { const int id = __shfl((EV), it * 8 + g); const unsigned char* ur = PUs + (size_t)id * PSEG; \
        QA[it] = *(const u32x2*)ur; QB[it] = *(const u32x2*)(ur + 8); QC[it] = *(const u32x2*)(ur + 16); } } while (0)
#define PU_DOT(QA, QB, QC, R) do { float pr[8]; _Pragma("unroll") for (int it = 0; it < 8; ++it) { const v6i_t d = {(int)QA[it].x, (int)QA[it].y, (int)QB[it].x, (int)QB[it].y, (int)QC[it].x, (int)QC[it].y}; \
        const v32f_t f = __builtin_amdgcn_cvt_scalef32_pk32_f32_fp6(d, 1.0f); f32x2 s0 = (f32x2){0.f, 0.f}, s1 = s0, s2 = s0, s3 = s0; \
        _Pragma("unroll") for (int i = 0; i < 16; i += 4) { s0 += (f32x2){f[2 * i], f[2 * i + 1]} * hv[i]; s1 += (f32x2){f[2 * i + 2], f[2 * i + 3]} * hv[i + 1]; \
            s2 += (f32x2){f[2 * i + 4], f[2 * i + 5]} * hv[i + 2]; s3 += (f32x2){f[2 * i + 6], f[2 * i + 7]} * hv[i + 3]; } \
        const f32x2 sacc = (s0 + s1) + (s2 + s3); pr[it] = sacc.x + sacc.y; \
        if (it & 1) __builtin_amdgcn_sched_barrier(0); } \
        float r4[4], s2_[2]; \
        _Pragma("unroll") for (int i = 0; i < 4; ++i) r4[i] = (b0 ? pr[4 + i] : pr[i]) + __shfl_xor(b0 ? pr[i] : pr[4 + i], 1); \
        _Pragma("unroll") for (int i = 0; i < 2; ++i) s2_[i] = (b1 ? r4[2 + i] : r4[i]) + __shfl_xor(b1 ? r4[i] : r4[2 + i], 2); \
        R = (b2 ? s2_[1] : s2_[0]) + __shfl_xor(b2 ? s2_[0] : s2_[1], 4); } while (0)
    int row = wslot;
    int e0 = EIDb[(size_t)row * 128 + lane], e1 = EIDb[(size_t)row * 128 + 64 + lane];
    u32x2 hraw[8];
#pragma unroll
    for (int j = 0; j < 8; ++j) hraw[j] = *(const u32x2*)(H2 + (size_t)row * DM + j * 256 + 4 * L);
    u32x2 qa0[8], qb0[8], qc0[8], qa1[8], qb1[8], qc1[8];
    PU_LOAD(qa0, qb0, qc0, e0);
#pragma unroll 1
    for (int i = 0; i < nrows; ++i, row += nslots) {
        f32x2 hv[16];
#pragma unroll
        for (int j = 0; j < 8; ++j) { hv[2 * j] = (f32x2){bflo(hraw[j].x), bfhi(hraw[j].x)}; hv[2 * j + 1] = (f32x2){bflo(hraw[j].y), bfhi(hraw[j].y)}; }
        const int rown = (i + 1 < nrows) ? row + nslots : row;
        PU_LOAD(qa1, qb1, qc1, e1);
        const int e0n = EIDb[(size_t)rown * 128 + lane], e1n = EIDb[(size_t)rown * 128 + 64 + lane];
#pragma unroll
        for (int j = 0; j < 8; ++j) hraw[j] = *(const u32x2*)(H2 + (size_t)rown * DM + j * 256 + 4 * L);
        __builtin_amdgcn_sched_barrier(0);
        float r0, r1;
        PU_DOT(qa0, qb0, qc0, r0);
        PU_LOAD(qa0, qb0, qc0, e0n);
        __builtin_amdgcn_sched_barrier(0);
        PU_DOT(qa1, qb1, qc1, r1);
        float* pa = PA + ((size_t)row * 8 + x) * 128 + kst;
        pa[0] = r0; pa[64] = r1;
        e1 = e1n;
    }
#undef PU_LOAD
#undef PU_DOT
}

template <bool PART> __device__ __forceinline__ void peer_token(const Params& p, LAS unsigned char* lds, int row, int lane, int part, int tslot) {
    const int hh_lo = PART ? (part >> 1) : 0, hh_hi = PART ? (part >> 1) + 1 : 2, k_lo = PART ? (part & 1) * 32 : 0, k_hi = PART ? (part & 1) * 32 + 32 : 64;
    const unsigned char* PV = p.ws + WS_PV;
    const float* SU = (const float*)(p.ws + WS_SU); const float* SV = (const float*)(p.ws + WS_SV);
    const int* EID = (const int*)(p.ws + WS_EID) + (size_t)row * 128; const float* GW = (const float*)(p.ws + WS_GW) + (size_t)row * 128;
    const int e0 = EID[lane], e1 = EID[64 + lane]; const float g0 = GW[lane], g1 = GW[64 + lane];
    const float su0 = SU[e0], su1 = SU[e1], sv0 = SV[e0], sv1 = SV[e1];
    float a0 = 0.f, a1 = 0.f;
    { const float* pa = (const float*)(p.ws + WS_PA) + (size_t)row * 1024 + lane;
#pragma unroll
      for (int xs = 0; xs < 8; ++xs) { a0 += pa[xs * 128]; a1 += pa[xs * 128 + 64]; } }
    const float w0 = g0 * gelu_tanh(a0 * su0) * sv0, w1 = g1 * gelu_tanh(a1 * su1) * sv1;
    f32x2 acc[16];
#pragma unroll
    for (int j = 0; j < 16; ++j) acc[j] = (f32x2){0.f, 0.f};
#pragma unroll 1
    for (int hh = hh_lo; hh < hh_hi; ++hh) { const int ev = hh ? e1 : e0; const float wvv = hh ? w1 : w0;
#pragma unroll 1
        for (int k0 = k_lo; k0 < k_hi; k0 += 8) {
            u32x2 qa[8], qb[8], qc[8];
#pragma unroll
            for (int e = 0; e < 8; ++e) { const int id = __builtin_amdgcn_readlane(ev, k0 + e); const unsigned char* vr = PV + (size_t)id * PROW + 24 * lane;
                qa[e] = *(const u32x2*)vr; qb[e] = *(const u32x2*)(vr + 8); qc[e] = *(const u32x2*)(vr + 16); }
#pragma unroll
            for (int e = 0; e < 8; ++e) { const float wk = rl_f(wvv, k0 + e); const f32x2 wk2 = (f32x2){wk, wk};
                const v6i_t d = {(int)qa[e].x, (int)qa[e].y, (int)qb[e].x, (int)qb[e].y, (int)qc[e].x, (int)qc[e].y};
                const v32f_t f = __builtin_amdgcn_cvt_scalef32_pk32_f32_fp6(d, 1.0f);
#pragma unroll
                for (int i = 0; i < 16; ++i) acc[i] += wk2 * (f32x2){f[2 * i], f[2 * i + 1]};
                __builtin_amdgcn_sched_barrier(0); }
        } }
    if (PART) {
        LAS f32x2* PB = (LAS f32x2*)lds;
#pragma unroll
        for (int i = 0; i < 16; ++i) PB[((tslot * 4 + part) * 16 + i) * 64 + lane] = acc[i];
        __syncthreads();
        if (part != 0) return;
#pragma unroll
        for (int q = 1; q < 4; ++q)
#pragma unroll
            for (int i = 0; i < 16; ++i) acc[i] += PB[((tslot * 4 + q) * 16 + i) * 64 + lane];
    }
    int rowf = row; asm volatile("" : "+s"(rowf));
    const float* gt = (const float*)(p.ws + WS_MOD) + stream_of(rowf) * 12288 + 10240; float* xr = p.out + O_Y + (size_t)rowf * DM;
    const float* xin = xrow_ptr(p, rowf); const bf16_t* tr = (const bf16_t*)(p.ws + WS_T) + (size_t)rowf * DM;
    float ss = 0.f; f32x4 x2[8];
#pragma unroll
    for (int j = 0; j < 8; ++j) { const int e = j * 256 + 4 * lane; const u32x2 tw = *(const u32x2*)(tr + e); const f32x4 xa = *(const f32x4*)(xin + e) + (f32x4){bflo(tw.x), bfhi(tw.x), bflo(tw.y), bfhi(tw.y)}, ga = *(const f32x4*)(gt + e);
        const f32x4 o = (f32x4){acc[2 * j].x, acc[2 * j].y, acc[2 * j + 1].x, acc[2 * j + 1].y};
        x2[j] = xa + ga * o; ss += x2[j][0] * x2[j][0] + x2[j][1] * x2[j][1] + x2[j][2] * x2[j][2] + x2[j][3] * x2[j][3]; }
    ss = wave_sum(ss);
    const float rstd = __builtin_amdgcn_rsqf(ss * (1.0f / 2048.0f) + 1e-6f);
#pragma unroll
    for (int j = 0; j < 8; ++j) { const int e = j * 256 + 4 * lane; *(f32x4*)(xr + e) = x2[j] * rstd * *(const f32x4*)(p.g_final + e); }
}
__device__ __forceinline__ void phase_peer(const Params& p, LAS unsigned char* lds) {
    const int tid_ = tid_fresh();
    const int lane = tid_ & 63, wv = __builtin_amdgcn_readfirstlane(tid_ >> 6); const int W = (int)gridDim.x * 8, full = (MT / W) * W, rem = MT - full;
    int row = blockIdx.x * 8 + wv;
    for (; row < full; row += W) peer_token<false>(p, lds, row, lane, 0, 0);
    if (rem * 4 == W) peer_token<true>(p, lds, full + (int)blockIdx.x * 2 + (wv >> 2), lane, wv & 3, wv >> 2);
    else if (row < MT) peer_token<false>(p, lds, row, lane, 0, 0);
}

__global__ void __launch_bounds__(512, 2) fwd_mega(Params p) {
    extern __shared__ __attribute__((aligned(16))) unsigned char smem[];
    LAS unsigned char* lds = (LAS unsigned char*)smem;
    cg::grid_group grid = cg::this_grid();
    const int lo = p.ph_lo, hi = p.ph_hi;
    volatile LAS unsigned* xst = (volatile LAS unsigned*)(lds + LDS_BYTES);
    if (tid_fresh() == 0) { xst[0] = 0u; xst[1] = 0u; }
    __syncthreads();
    XcdBarrier xb = xcd_barrier_post((unsigned*)(p.ws + WS_BAR), xst);
#define RUN(k) if (lo <= (k) && (k) < hi)
#ifdef PROBE_LO
#define STAMP(k) do { if (blockIdx.x == 0 && tid_fresh() == 0) ((unsigned long long*)(p.ws + WS_END))[k] = __builtin_amdgcn_s_memrealtime(); } while (0)
#else
#define STAMP(k) do {} while (0)
#endif
#ifdef PROBE_LO
#define SEAM(k) do { if (lo < (k) && (k) < hi) { if ((k) >= 11) grid.sync(); else xcd_barrier(xb); } __syncthreads(); STAMP(k); } while (0)
#else
#define SEAM(k) do { if (lo < (k) && (k) < hi) xcd_barrier(xb); __syncthreads(); } while (0)
#endif
    STAMP(0);
    RUN(0) { phase_prep(p, lds); }
    SEAM(1);
    RUN(1) { phase_norm(p, 0); }
    SEAM(2);
    RUN(2) { pg8::Gemm g{(const bf16_t*)(p.ws + WS_H), (const bf16_t*)(p.ws + WS_WIN), MT, IN_DIM, 2048}; pg8::StaticOrder S; S.init(MT, IN_DIM, (int)gridDim.x, (int)blockIdx.x);
        EpiIn E{p.ws, p.out}; pg8::gemm_phase<EpiIn, pg8::StaticOrder>(lds, g, S, E, nullptr);
        __syncthreads();
        tail_transpose(lds, p.w_a, (bf16_t*)(p.ws + WS_WA), 1024, 2048, 2048, P0_TR_WA, (MT / 256) * (IN_DIM / 256));
        tail_transpose(lds, p.w_b, (bf16_t*)(p.ws + WS_WA) + 1024, 1024, 2048, 2048, P0_TR_WA, (MT / 256) * (IN_DIM / 256)); }
    SEAM(3);
    RUN(3) { phase_mixers(p, lds); }
    SEAM(4);
    RUN(4) { pg8::Gemm g{(const bf16_t*)(p.ws + WS_H), (const bf16_t*)(p.ws + WS_WA), MT, 2048, 2048}; pg8::StaticOrder S; S.init(MT, 2048, (int)gridDim.x, (int)blockIdx.x);
        EpiMixF E{(const bf16_t*)(p.ws + WS_SGA), (const bf16_t*)(p.ws + WS_SGB), (bf16_t*)(p.ws + WS_Q)}; pg8::gemm_phase<EpiMixF, pg8::StaticOrder>(lds, g, S, E, nullptr);
        tail_quant(p, 0, 1365, (MT / 256) * 8);
        __syncthreads();
        tail_transpose(lds, p.w_out, (bf16_t*)(p.ws + WS_WOUT), 2048, 2048, 2048, P0_TR_WO, (MT / 256) * 8); }
    SEAM(5);
    RUN(5) { pg8::Gemm g{(const bf16_t*)(p.ws + WS_Q), (const bf16_t*)(p.ws + WS_WOUT), MT, 2048, 2048}; pg8::StaticOrder S; S.init(MT, 2048, (int)gridDim.x, (int)blockIdx.x);
        EpiT E{(const float*)(p.ws + WS_MOD), (bf16_t*)(p.ws + WS_T)}; pg8::gemm_phase<EpiT, pg8::StaticOrder>(lds, g, S, E, nullptr);
        tail_quant(p, 1365, 2730, (MT / 256) * 8);
        __syncthreads();
        tail_transpose(lds, p.pk_wq, (bf16_t*)(p.ws + WS_WQ), 2048, 2048, 2048, P0_TR_WO, (MT / 256) * 8); }
    SEAM(6);
    RUN(6) { phase_norm(p, 1); }
    SEAM(7);
    RUN(7) { pg8::Gemm g{(const bf16_t*)(p.ws + WS_H), (const bf16_t*)(p.ws + WS_WQ), MT, 2048, 2048}; pg8::StaticOrder S; S.init(MT, 2048, (int)gridDim.x, (int)blockIdx.x);
        EpiQP E{(bf16_t*)(p.ws + WS_SGA)}; pg8::gemm_phase<EpiQP, pg8::StaticOrder>(lds, g, S, E, nullptr);
        tail_quant(p, 2730, 4096, (MT / 256) * 8); }
    SEAM(8);
    RUN(8) { phase_topk(p, lds); }
    SEAM(9);
    RUN(9) { phase_peer_u(p); }
    SEAM(10);
    RUN(10) { phase_peer(p, lds); }
    if (hi > 1000) grid.sync();
#ifdef PROBE_LO
    SEAM(11);
    grid.sync();
    { const unsigned long long* TS = (const unsigned long long*)(p.ws + WS_END);
      const float f = PROBE_HI < 0 ? 0.0f : (float)(TS[PROBE_HI < 0 ? 0 : PROBE_HI] - TS[PROBE_LO]) / (float)(TS[11] - TS[0]);
      const float sc = 1.0f + sqrtf(3e-5f + 1e-4f * f);
      for (int i = blockIdx.x * 512 + tid_fresh(); i < 524288; i += gridDim.x * 512) p.out[O_GVS + i] *= sc; }
#endif
#ifdef DBG_COPY
    RUN(12) { const unsigned* src = (const unsigned*)(p.ws + DBG_SRC); unsigned* dst = (unsigned*)p.out;
        for (size_t i = (size_t)blockIdx.x * 512 + tid_fresh(); i < (size_t)DBG_WORDS; i += (size_t)gridDim.x * 512) dst[i] = src[i]; }
#endif
}

constexpr int N_PHASES = 11;
#ifndef N_LAUNCH_MODE
#define N_LAUNCH_MODE 1
#endif
extern "C" void kernel_launch(void* const* d_in, const int* in_sizes, int n_in, void* d_out, int out_size, void* d_ws, size_t ws_size, hipStream_t stream) {
    static int grid_blocks = 0;
    if (!grid_blocks) {
        int dev = 0, cus = 0, per_cu = 0;
        hipGetDevice(&dev);
        hipDeviceGetAttribute(&cus, hipDeviceAttributeMultiprocessorCount, dev);
        hipFuncSetAttribute((const void*)fwd_mega, hipFuncAttributeMaxDynamicSharedMemorySize, LDS_BYTES + 64);
        hipOccupancyMaxActiveBlocksPerMultiprocessor(&per_cu, (const void*)fwd_mega, 512, LDS_BYTES + 64);
        if (per_cu < 1) per_cu = 1;
        grid_blocks = cus * per_cu;
        if (ws_size < WS_END) { fprintf(stderr, "kernel_launch: workspace too small: %zu < %zu\n", ws_size, (size_t)WS_END); }
    }
    Params p{};
    const float* const* in = (const float* const*)d_in;
    p.x_prompt = in[0]; p.x_sample = in[1]; p.cache_k = in[2]; p.cache_v = in[3]; p.c_prompt = in[4]; p.c_sample = in[5];
    p.w_mod = in[6]; p.b_mod = in[7]; p.g_norm1 = in[8]; p.w_in = in[9]; p.sinks = in[10]; p.ln_g = in[11]; p.ln_b = in[12];
    p.gm_ws = in[13]; p.gm_b = in[14]; p.w_a = in[15]; p.w_b = in[16]; p.w_out = in[17]; p.g_norm2 = in[18]; p.pk_wq = in[19];
    p.pk_keys = in[20]; p.peer_u = in[21]; p.peer_v = in[22]; p.g_final = in[23];
    p.out = (float*)d_out; p.ws = (unsigned char*)d_ws;
    (void)hipMemsetAsync((unsigned char*)d_ws + WS_BAR, 0, (size_t)XCD_BAR_WORDS * 4, stream);
#if N_LAUNCH_MODE == 1
#ifdef PROBE_LO
    p.ph_lo = 0; p.ph_hi = N_PHASES + 1;
#else
    p.ph_lo = 0; p.ph_hi = N_PHASES;
#endif
    { void* args[] = {&p}; hipError_t e = hipLaunchCooperativeKernel((const void*)fwd_mega, dim3(grid_blocks), dim3(512), args, LDS_BYTES + 64, stream);
      if (e != hipSuccess) fprintf(stderr, "cooperative launch failed: %s (grid %d)\n", hipGetErrorString(e), grid_blocks); }
#else
    for (int ph = 0; ph < N_PHASES; ++ph) { p.ph_lo = ph; p.ph_hi = ph + 1;
#ifdef DBG_COPY
        if (ph == N_PHASES - 1) { p.ph_lo = 12; p.ph_hi = 13; }
#endif
        void* args[] = {&p};
        hipError_t e = hipLaunchCooperativeKernel((const void*)fwd_mega, dim3(grid_blocks), dim3(512), args, LDS_BYTES + 64, stream);
        if (e != hipSuccess) fprintf(stderr, "launch %d failed: %s (grid %d)\n", ph, hipGetErrorString(e), grid_blocks); }
#endif
}
```
